# Optimizing an MI355X kernel written in HIP

```python
import math
import jax, jax.numpy as jnp
from jax import lax
import numpy as np

D_MODEL = 2048
BATCH = 8
SEQ = 2048
DEPTH = 4
DEC_BATCH = 4
DEC_SEQ = 4096
PAST_LEN = 128

D_MIX = D_MODEL
W_A = D_MIX // 4
W_B = D_MIX // 4
W_C = D_MIX // 4
W_D = D_MIX // 4
CHUNK = 128
A_HEADS = 4
A_HEAD_DIM = W_A // A_HEADS
CONV_WIDTH = 31
SHORT_CONV_WIDTH = 3
ATT_HEAD_DIM = 64
Q_HEADS = W_C // ATT_HEAD_DIM
KV_HEADS = 2
Q_PER_KV = Q_HEADS // KV_HEADS
WINDOW = 128
BLOCK = 128
D_IN = 3 * W_A + 3 * W_B + (W_C + 2 * KV_HEADS * ATT_HEAD_DIM + W_C) + 4 * W_D
DEEPNORM_ALPHA = (2.0 * DEPTH) ** 0.25
DEEPNORM_BETA = (8.0 * DEPTH) ** -0.25
LN_EPS = 1e-5
NEG_BIG = -1e30

kernel_name = "hybrid_parallel_group_encoder"


def _layernorm(x, g, b):
    xf = x.astype(jnp.float32)
    mu = xf.mean(-1, keepdims=True)
    var = jnp.square(xf - mu).mean(-1, keepdims=True)
    y = (xf - mu) * lax.rsqrt(var + LN_EPS)
    return (y * g.astype(jnp.float32) + b.astype(jnp.float32)).astype(x.dtype)


def _depthwise_conv(x, w):
    k = w.shape[0]
    return lax.conv_general_dilated(
        x, w[:, None, :].astype(x.dtype), window_strides=(1,),
        padding=((k // 2, k // 2),), dimension_numbers=("NWC", "WIO", "NWC"),
        feature_group_count=x.shape[-1])


def _spatial_gating(u, v, ln_g, ln_b, w_s, b_s):
    bn, s, _ = v.shape
    v = _layernorm(v, ln_g, ln_b)
    v = v.reshape(bn, s // CHUNK, CHUNK, A_HEADS, A_HEAD_DIM)
    mixed = jnp.einsum("hts,bcshd->bcthd", w_s, v) + b_s.T[None, None, :, :, None]
    return u * mixed.reshape(bn, s, W_A)


def _conformer_conv(a, gate, conv_w, conv_b, ln_g, ln_b):
    y = a * jax.nn.sigmoid(gate)
    y = _depthwise_conv(y, conv_w) + conv_b
    y = _layernorm(y, ln_g, ln_b)
    return jax.nn.silu(y)


def _short_gated_conv(bg, cg, xin, conv_w):
    return bg * _depthwise_conv(cg * xin, conv_w)


def _window_attention(q, k, v, sink):
    bn, s, _ = q.shape
    nb = s // BLOCK
    q = q.reshape(bn, nb, BLOCK, KV_HEADS, Q_PER_KV, ATT_HEAD_DIM)
    pad = ((0, 0), (BLOCK, BLOCK), (0, 0))
    k = jnp.pad(k, pad).reshape(bn, nb + 2, BLOCK, KV_HEADS, ATT_HEAD_DIM)
    v = jnp.pad(v, pad).reshape(bn, nb + 2, BLOCK, KV_HEADS, ATT_HEAD_DIM)
    kb = jnp.concatenate([k[:, :-2], k[:, 1:-1], k[:, 2:]], axis=2)
    vb = jnp.concatenate([v[:, :-2], v[:, 1:-1], v[:, 2:]], axis=2)
    scores = jnp.einsum("bnqgrd,bnkgd->bngrqk", q, kb).astype(jnp.float32)
    scores = scores * (ATT_HEAD_DIM ** -0.5)
    qi = jnp.arange(BLOCK)[:, None]
    kj = jnp.arange(3 * BLOCK)[None, :]
    dist = jnp.abs(qi - kj + BLOCK)
    kpos = (jnp.arange(nb)[:, None] - 1) * BLOCK + jnp.arange(3 * BLOCK)[None, :]
    valid = (dist <= WINDOW)[None] & ((kpos >= 0) & (kpos < s))[:, None, :]
    slopes = jnp.exp2(-(8.0 / Q_HEADS) * (jnp.arange(Q_HEADS, dtype=jnp.float32) + 1.0))
    slopes = slopes.reshape(KV_HEADS, Q_PER_KV)
    alibi = -slopes[:, :, None, None] * dist.astype(jnp.float32)[None, None]
    scores = jnp.where(valid[None, :, None, None], scores + alibi[None, None], NEG_BIG)
    sk = sink.astype(jnp.float32).reshape(KV_HEADS, Q_PER_KV)[None, None, :, :, None]
    m = jnp.maximum(scores.max(-1), sk)
    p = jnp.exp(scores - m[..., None])
    denom = p.sum(-1) + jnp.exp(sk - m)
    p = (p / denom[..., None]).astype(vb.dtype)
    out = jnp.einsum("bngrqk,bnkgd->bnqgrd", p, vb)
    return out.reshape(bn, s, W_C)


def _layer(x, w_in, w_out, sgu_ln_g, sgu_ln_b, sgu_w, sgu_b, cm_conv_w, cm_conv_b,
           cm_ln_g, cm_ln_b, attn_sink, sc_conv_w, post_ln_g, post_ln_b):
    h = jnp.einsum("bsd,de->bse", x, w_in)
    kv_w = KV_HEADS * ATT_HEAD_DIM
    sizes = [W_A, W_A, W_A, W_B, W_B, W_B, W_C, kv_w, kv_w, W_C, W_D, W_D, W_D, W_D]
    offs = list(np.cumsum(sizes)[:-1])
    (a_u, a_v, a_g, b_a, b_b, b_g, c_q, c_k, c_v, c_g,
     d_b, d_c, d_x, d_g) = jnp.split(h, offs, axis=-1)
    ya = _spatial_gating(a_u, a_v, sgu_ln_g, sgu_ln_b, sgu_w, sgu_b) * jax.nn.silu(a_g)
    yb = _conformer_conv(b_a, b_b, cm_conv_w, cm_conv_b, cm_ln_g, cm_ln_b) * jax.nn.silu(b_g)
    yc = _window_attention(c_q, c_k, c_v, attn_sink) * jax.nn.silu(c_g)
    yd = _short_gated_conv(d_b, d_c, d_x, sc_conv_w) * jax.nn.silu(d_g)
    y = jnp.concatenate([ya, yb, yc, yd], axis=-1)
    out = jnp.einsum("bse,ed->bsd", y, w_out)
    return _layernorm(DEEPNORM_ALPHA * x + out, post_ln_g, post_ln_b)


def _trunk(x, w_in, w_out, sgu_ln_g, sgu_ln_b, sgu_w, sgu_b, cm_conv_w, cm_conv_b,
           cm_ln_g, cm_ln_b, attn_sink, sc_conv_w, post_ln_g, post_ln_b):
    for l in range(DEPTH):
        x = _layer(x, w_in[l], w_out[l], sgu_ln_g[l], sgu_ln_b[l], sgu_w[l], sgu_b[l],
                   cm_conv_w[l], cm_conv_b[l], cm_ln_g[l], cm_ln_b[l], attn_sink[l],
                   sc_conv_w[l], post_ln_g[l], post_ln_b[l])
    return x


def setup_inputs(seed: int = 0) -> dict:
    key = jax.random.key(seed)
    ks = jax.random.split(key, 18)
    f32 = jnp.float32
    nrm = lambda k, shape, scale: jax.random.normal(k, shape, f32) * scale
    return {
        "x_prompt": nrm(ks[0], (BATCH, SEQ, D_MODEL), 1.0),
        "x_sample": nrm(ks[1], (DEC_BATCH, DEC_SEQ, D_MODEL), 1.0),
        "w_in": nrm(ks[2], (DEPTH, D_MODEL, D_IN), D_MODEL ** -0.5),
        "w_out": nrm(ks[3], (DEPTH, D_MIX, D_MODEL), DEEPNORM_BETA * D_MIX ** -0.5),
        "sgu_ln_g": 1.0 + nrm(ks[4], (DEPTH, W_A), 0.02),
        "sgu_ln_b": nrm(ks[5], (DEPTH, W_A), 0.02),
        "sgu_w": nrm(ks[6], (DEPTH, A_HEADS, CHUNK, CHUNK), CHUNK ** -0.5),
        "sgu_b": 1.0 + nrm(ks[7], (DEPTH, A_HEADS, CHUNK), 0.02),
        "cm_conv_w": nrm(ks[8], (DEPTH, CONV_WIDTH, W_B), CONV_WIDTH ** -0.5),
        "cm_conv_b": nrm(ks[9], (DEPTH, W_B), 0.02),
        "cm_ln_g": 1.0 + nrm(ks[10], (DEPTH, W_B), 0.02),
        "cm_ln_b": nrm(ks[11], (DEPTH, W_B), 0.02),
        "attn_sink": nrm(ks[12], (DEPTH, Q_HEADS), 0.5),
        "sc_conv_w": nrm(ks[13], (DEPTH, SHORT_CONV_WIDTH, W_D), SHORT_CONV_WIDTH ** -0.5),
        "post_ln_g": 1.0 + nrm(ks[14], (DEPTH, D_MODEL), 0.02),
        "post_ln_b": nrm(ks[15], (DEPTH, D_MODEL), 0.02),
    }


def reference(x_prompt, x_sample, w_in, w_out, sgu_ln_g, sgu_ln_b, sgu_w, sgu_b,
              cm_conv_w, cm_conv_b, cm_ln_g, cm_ln_b, attn_sink, sc_conv_w,
              post_ln_g, post_ln_b):
    y_prompt = _trunk(x_prompt, w_in, w_out, sgu_ln_g, sgu_ln_b, sgu_w, sgu_b,
                      cm_conv_w, cm_conv_b, cm_ln_g, cm_ln_b, attn_sink, sc_conv_w,
                      post_ln_g, post_ln_b)
    y_sample = _trunk(x_sample, w_in, w_out, sgu_ln_g, sgu_ln_b, sgu_w, sgu_b,
                      cm_conv_w, cm_conv_b, cm_ln_g, cm_ln_b, attn_sink, sc_conv_w,
                      post_ln_g, post_ln_b)
    return (y_prompt, y_sample)
```

```cpp
#include <hip/hip_runtime.h>
#include <hip/hip_cooperative_groups.h>
#include <cstdio>
namespace cg = cooperative_groups;
namespace pg8 {
#define PG8_LAS __attribute__((address_space(3)))
typedef unsigned short bf16_t;
typedef short bf16x8 __attribute__((ext_vector_type(8)));
typedef float f32x4 __attribute__((ext_vector_type(4)));
typedef unsigned u32x4 __attribute__((ext_vector_type(4)));
constexpr int BM = 256, BK = 64, HALF = 128, HTB = HALF * BK * 2  , STAGE_BYTES = 8 * HTB, NXCD = 8, WGM = 8;

__host__ __device__ __forceinline__ int lds_byte(int r, int c) { const int st = (r >> 4) * 2 + (c >> 5), rr = r & 15, cc = c & 31, ob = rr * 64 + cc * 2; return st * 1024 + (ob ^ (((ob >> 9) & 1) << 5)); }
__host__ __device__ __forceinline__ void stage_rc(int b, int& R, int& C) { const int st = b / 1024, sb = b % 1024, swz = sb ^ (((sb >> 9) & 1) << 5); R = (st >> 1) * 16 + swz / 64; C = (st & 1) * 32 + (swz % 64) / 2; }
__host__ __device__ __forceinline__ int perm32(int rho) { const int n = rho >> 4, i = rho & 15; return 8 * (i >> 2) + 4 * n + (i & 3); }

struct Unit { int pm, pn; };
struct Gemm { const bf16_t* A; const bf16_t* Bt; int M, N, K; };

struct StaticOrder {
    int nM, nN, nwg, G, c;
    __host__ __device__ void init(int M, int N, int G_, int c_) { nM = M / BM; nN = N / BM; nwg = nM * nN; G = G_; c = c_; }
    __host__ __device__ bool next(int i, Unit& u) const {
        const long L = (long)i * G + c; if (L >= nwg) return false;
        int wgid = (int)L; { const int q = nwg / NXCD, r = nwg % NXCD, xcd = wgid % NXCD, off = wgid / NXCD; wgid = (xcd < r ? xcd * (q + 1) : r * (q + 1) + (xcd - r) * q) + off; }
        const int nig = WGM * nN, gid = wgid / nig, fm = gid * WGM, gsz = (nM - fm) < WGM ? (nM - fm) : WGM;
        u.pm = fm + ((wgid % nig) % gsz); u.pn = (wgid % nig) / gsz; return true;
    }
    __device__ __forceinline__ void a_ready(const Unit&) const {}
    __device__ __forceinline__ void done(const Unit&) const {}
};

__device__ __forceinline__ unsigned cvt_pk_bf16(float lo, float hi) { unsigned r; asm volatile("v_cvt_pk_bf16_f32 %0, %1, %2" : "=v"(r) : "v"(lo), "v"(hi)); return r; }
typedef float f32x2 __attribute__((ext_vector_type(2)));
__device__ __forceinline__ f32x2 gelu_pk(f32x2 v) {
    const f32x2 av = __builtin_elementwise_abs(v), d = av * 0.2316418882f + 1.0f;
    f32x2 t; t.x = __builtin_amdgcn_rcpf(d.x); t.y = __builtin_amdgcn_rcpf(d.y);
    f32x2 q = t * 0.5307027145f + (-0.7265760135f); q = q * t + 0.7107068705f; q = q * t + (-0.142248368f); q = q * t + 0.127414796f; q = q * t;
    const f32x2 s = (v * v) * (-0.72134752044f);
    f32x2 e; e.x = __builtin_amdgcn_exp2f(s.x); e.y = __builtin_amdgcn_exp2f(s.y);
    const f32x2 m = v * (q * e), r = v - m;
    f32x2 o; o.x = v.x < 0.f ? m.x : r.x; o.y = v.y < 0.f ? m.y : r.y; return o;
}

struct EpiF32 {
    static constexpr bool PERM = false, AFTER_DRAIN = false;
    float* C; int ldc; const float* bias;
    __device__ __forceinline__ void operator()(const f32x4 (&acc)[2][2][4][2], const Unit& u, int wr, int wc, int fr, int fq) const {
        const int row0 = u.pm * BM + wr * 64 + fr, col0 = u.pn * BM + wc * 32 + 4 * fq;
        f32x4 bv[2][2];
#pragma unroll
        for (int bj = 0; bj < 2; ++bj)
#pragma unroll
            for (int n = 0; n < 2; ++n) bv[bj][n] = bias ? *(const f32x4*)(bias + col0 + bj * HALF + n * 16) : (f32x4){0.f, 0.f, 0.f, 0.f};
#pragma unroll
        for (int ai = 0; ai < 2; ++ai)
#pragma unroll
            for (int m = 0; m < 4; ++m) { float* rowp = C + (size_t)(row0 + ai * HALF + m * 16) * ldc + col0;
#pragma unroll
                for (int bj = 0; bj < 2; ++bj)
#pragma unroll
                    for (int n = 0; n < 2; ++n) *(f32x4*)(rowp + bj * HALF + n * 16) = acc[ai][bj][m][n] + bv[bj][n]; }
    }
};
template <int ACT  > struct EpiBf16 {
    static constexpr bool PERM = true, AFTER_DRAIN = false;
    bf16_t* O; int ldc; const float* bias; int split_cols; size_t split_stride;
    __device__ __forceinline__ void operator()(const f32x4 (&acc)[2][2][4][2], const Unit& u, int wr, int wc, int fr, int fq) const {
        const int row0 = u.pm * BM + wr * 64 + fr; int colt = u.pn * BM; bf16_t* base = O;
        if (split_cols) { const int t = colt / split_cols; base += (size_t)t * split_stride; colt -= t * split_cols; }
        const int col0 = colt + wc * 32 + 8 * fq, bcol0 = u.pn * BM + wc * 32 + 8 * fq;
        f32x4 bv[2][2];
#pragma unroll
        for (int bj = 0; bj < 2; ++bj)
#pragma unroll
            for (int n = 0; n < 2; ++n) bv[bj][n] = bias ? *(const f32x4*)(bias + bcol0 + bj * HALF + 4 * n) : (f32x4){0.f, 0.f, 0.f, 0.f};
#pragma unroll
        for (int ai = 0; ai < 2; ++ai)
#pragma unroll
            for (int m = 0; m < 4; ++m) { bf16_t* rowp = base + (size_t)(row0 + ai * HALF + m * 16) * ldc + col0;
#pragma unroll
                for (int bj = 0; bj < 2; ++bj) { f32x4 v0 = acc[ai][bj][m][0] + bv[bj][0], v1 = acc[ai][bj][m][1] + bv[bj][1];
                    if (ACT == 1) { f32x2 a = gelu_pk((f32x2){v0[0], v0[1]}), b = gelu_pk((f32x2){v0[2], v0[3]}), c = gelu_pk((f32x2){v1[0], v1[1]}), d = gelu_pk((f32x2){v1[2], v1[3]});
                        v0 = (f32x4){a.x, a.y, b.x, b.y}; v1 = (f32x4){c.x, c.y, d.x, d.y}; }
                    if (ACT == 2) {
#pragma unroll
                        for (int j = 0; j < 4; ++j) { v0[j] = 0.5f * v0[j] * (1.0f + erff(v0[j] * 0.70710678f)); v1[j] = 0.5f * v1[j] * (1.0f + erff(v1[j] * 0.70710678f)); } }
                    u32x4 w; w.x = cvt_pk_bf16(v0[0], v0[1]); w.y = cvt_pk_bf16(v0[2], v0[3]); w.z = cvt_pk_bf16(v1[0], v1[1]); w.w = cvt_pk_bf16(v1[2], v1[3]);
                    *(u32x4*)(rowp + bj * HALF) = w; } }
    }
};

template <class Epi, class Sched, bool STAMP = false>
__device__ __forceinline__ void gemm_phase(PG8_LAS unsigned char* lds, const Gemm g, const Sched& S, const Epi& E, unsigned long long* stamps) {
    const int tid = threadIdx.x, wid = __builtin_amdgcn_readfirstlane(tid >> 6), lane = tid & 63, wr = wid >> 2, wc = wid & 3, fr = lane & 15, fq = lane >> 4;
    const int K = g.K, nt = K / BK;
    int ts_lo = 0, ts_hi = 0, nts = 0; const unsigned long long rt_entry = STAMP ? (unsigned long long)wall_clock64() : 0ull;
#define PG8_STAMP() do { if (STAMP && wid == 0 && nts < 64) { const unsigned long long _c = (unsigned long long)clock64(); \
        ts_lo = (lane == nts) ? (int)(unsigned)_c : ts_lo; ts_hi = (lane == nts) ? (int)(unsigned)(_c >> 32) : ts_hi; ++nts; } } while (0)
    PG8_STAMP();
    unsigned voffA[2], voffB[2];
#pragma unroll
    for (int i = 0; i < 2; ++i) { int R, C; stage_rc(tid * 16 + i * 8192, R, C); const int Rb = Epi::PERM ? ((R & ~31) + perm32(R & 31)) : R;
        voffA[i] = (unsigned)(R * K + C) * 2u; voffB[i] = (unsigned)(Rb * K + C) * 2u; }
    const size_t kstep = (size_t)(BK * 2);
    const size_t hstep = (size_t)HALF * K * 2;
    const size_t tstep = 2 * hstep;
    const unsigned ldsw = (unsigned)wid * 1024u;
    const int aoff = lds_byte(wr * 64 + fr, fq * 8), boff = lds_byte(wc * 32 + fr, fq * 8);
#define PG8_SA(b, h) (((b) * 2 + (h)) * HTB)
#define PG8_SB(b, h) ((4 + (b) * 2 + (h)) * HTB)
#define PG8_STAGE(bufoff, gbase, voff) do { _Pragma("unroll") for (int _i = 0; _i < 2; ++_i) \
        __builtin_amdgcn_global_load_lds((const unsigned*)((const char*)(gbase) + (voff)[_i]), (PG8_LAS unsigned*)(lds + (bufoff) + ldsw + _i * 8192), 16, 0, 0); } while (0)
#define PG8_LDA(dst, b, h) do { _Pragma("unroll") for (int m = 0; m < 4; ++m) _Pragma("unroll") for (int k = 0; k < 2; ++k) dst[m][k] = *(const PG8_LAS bf16x8*)(lds + PG8_SA(b, h) + aoff + m * 2048 + k * 1024); } while (0)
#define PG8_LDB(dst, b, h) do { _Pragma("unroll") for (int n = 0; n < 2; ++n) _Pragma("unroll") for (int k = 0; k < 2; ++k) dst[n][k] = *(const PG8_LAS bf16x8*)(lds + PG8_SB(b, h) + boff + n * 2048 + k * 1024); } while (0)
#define PG8_MMA(ai, bj, At, Bt) do { __builtin_amdgcn_s_setprio(1); _Pragma("unroll") for (int m = 0; m < 4; ++m) _Pragma("unroll") for (int n = 0; n < 2; ++n) _Pragma("unroll") for (int k = 0; k < 2; ++k) \
        acc[ai][bj][m][n] = __builtin_amdgcn_mfma_f32_16x16x32_bf16(Bt[n][k], At[m][k], acc[ai][bj][m][n], 0, 0, 0); __builtin_amdgcn_s_setprio(0); } while (0)
#define PG8_WAIT_V(n) asm volatile("s_waitcnt vmcnt(" #n ")" ::: "memory")
#define PG8_WAIT_L(n) asm volatile("s_waitcnt lgkmcnt(" #n ")" ::: "memory")
#define PG8_BAR __builtin_amdgcn_s_barrier()
#define PG8_SCHED __builtin_amdgcn_sched_barrier(0)
    Unit cur, nxt; int ui = 0;
    if (!S.next(0, cur)) return;
    f32x4 acc[2][2][4][2];
#pragma unroll
    for (int a = 0; a < 2; ++a)
#pragma unroll
        for (int b = 0; b < 2; ++b)
#pragma unroll
            for (int m = 0; m < 4; ++m)
#pragma unroll
                for (int n = 0; n < 2; ++n) acc[a][b][m][n] = (f32x4){0.f, 0.f, 0.f, 0.f};
    bf16x8 At[4][2], B0[2][2], B1[2][2];
    const char* cA = (const char*)g.A + (size_t)cur.pm * tstep; const char* cB = (const char*)g.Bt + (size_t)cur.pn * tstep;
    S.a_ready(cur);
    PG8_STAGE(PG8_SB(0, 0), cB, voffB); PG8_STAGE(PG8_SA(0, 0), cA, voffA); PG8_STAGE(PG8_SB(0, 1), cB + hstep, voffB); PG8_STAGE(PG8_SA(0, 1), cA + hstep, voffA);
    if (wr == 1) PG8_BAR;
    PG8_WAIT_V(4); PG8_BAR;
    PG8_STAGE(PG8_SB(1, 0), cB + kstep, voffB); PG8_STAGE(PG8_SA(1, 0), cA + kstep, voffA); PG8_STAGE(PG8_SB(1, 1), cB + hstep + kstep, voffB);
    PG8_WAIT_V(6); PG8_BAR;
    PG8_STAMP();
    for (;;) {
        const bool has_next = S.next(ui + 1, nxt);
        const char* nA = has_next ? (const char*)g.A + (size_t)nxt.pm * tstep : cA; const char* nB = has_next ? (const char*)g.Bt + (size_t)nxt.pn * tstep : cB;
        for (int t = 0; t < nt; t += 2) {
            const bool last = (t == nt - 2);
            const char* a1 = cA + (size_t)(t + 1) * kstep;
            const char* a2 = last ? nA : cA + (size_t)(t + 2) * kstep; const char* b2 = last ? nB : cB + (size_t)(t + 2) * kstep;
            const char* a3 = a2 + kstep; const char* b3 = b2 + kstep;
            if (last && has_next) S.a_ready(nxt);
            PG8_LDB(B0, 0, 0); PG8_SCHED; PG8_LDA(At, 0, 0); PG8_STAGE(PG8_SA(1, 1), a1 + hstep, voffA);
            PG8_WAIT_L(8); PG8_BAR; PG8_WAIT_L(0); PG8_MMA(0, 0, At, B0); PG8_BAR; PG8_SCHED;
            PG8_LDB(B1, 0, 1); PG8_STAGE(PG8_SB(0, 0), b2, voffB);
            PG8_BAR; PG8_WAIT_L(0); PG8_MMA(0, 1, At, B1); PG8_BAR;
            PG8_LDA(At, 0, 1); PG8_STAGE(PG8_SA(0, 0), a2, voffA);
            PG8_BAR; PG8_WAIT_L(0); PG8_MMA(1, 0, At, B0); PG8_BAR; PG8_SCHED;
            PG8_STAGE(PG8_SB(0, 1), b2 + hstep, voffB);
            PG8_WAIT_V(6); PG8_BAR; PG8_MMA(1, 1, At, B1); PG8_BAR;
            PG8_LDB(B0, 1, 0); PG8_SCHED; PG8_LDA(At, 1, 0); PG8_STAGE(PG8_SA(0, 1), a2 + hstep, voffA);
            PG8_WAIT_L(8); PG8_BAR; PG8_WAIT_L(0); PG8_MMA(0, 0, At, B0); PG8_BAR; PG8_SCHED;
            PG8_LDB(B1, 1, 1); PG8_STAGE(PG8_SB(1, 0), b3, voffB);
            PG8_BAR; PG8_WAIT_L(0); PG8_MMA(0, 1, At, B1); PG8_BAR;
            PG8_LDA(At, 1, 1); PG8_STAGE(PG8_SA(1, 0), a3, voffA);
            PG8_BAR; PG8_WAIT_L(0); PG8_MMA(1, 0, At, B0); PG8_BAR; PG8_SCHED;
            PG8_STAGE(PG8_SB(1, 1), b3 + hstep, voffB);
            PG8_WAIT_V(6); PG8_BAR; PG8_MMA(1, 1, At, B1); PG8_BAR;
        }
        PG8_STAMP();
        if constexpr (!Epi::AFTER_DRAIN) { E(acc, cur, wr, wc, fr, fq); S.done(cur); }
        PG8_STAMP();
        if (!has_next) break;
#pragma unroll
        for (int a = 0; a < 2; ++a)
#pragma unroll
            for (int b = 0; b < 2; ++b)
#pragma unroll
                for (int m = 0; m < 4; ++m)
#pragma unroll
                    for (int n = 0; n < 2; ++n) acc[a][b][m][n] = (f32x4){0.f, 0.f, 0.f, 0.f};
        cur = nxt; cA = nA; cB = nB; ++ui;
    }
    PG8_WAIT_V(0);
    if (wr == 0) PG8_BAR;
    PG8_BAR;
    if constexpr (Epi::AFTER_DRAIN) { E.fused(acc, cur, wr, wc, fr, fq, lds, wid, lane); S.done(cur); }
    PG8_STAMP();
    if (STAMP && wid == 0) { stamps[lane] = lane < nts ? (((unsigned long long)(unsigned)ts_hi << 32) | (unsigned)ts_lo) : 0ull;
        if (lane == 62) stamps[62] = rt_entry; if (lane == 63) stamps[63] = (unsigned long long)wall_clock64(); }
#undef PG8_STAMP
#undef PG8_SA
#undef PG8_SB
#undef PG8_STAGE
#undef PG8_LDA
#undef PG8_LDB
#undef PG8_MMA
#undef PG8_WAIT_V
#undef PG8_WAIT_L
#undef PG8_BAR
#undef PG8_SCHED
}
}

#ifndef MK_COOP
#define MK_COOP 1
#endif
#define LAS __attribute__((address_space(3)))
typedef unsigned short bf16_t;
typedef short bf16x8 __attribute__((ext_vector_type(8)));
typedef short s16x4 __attribute__((ext_vector_type(4)));
typedef float f32x4 __attribute__((ext_vector_type(4)));
typedef float f32x2 __attribute__((ext_vector_type(2)));
typedef unsigned u32x4 __attribute__((ext_vector_type(4)));
typedef unsigned u32x2 __attribute__((ext_vector_type(2)));

constexpr int MTOK = 32768, DM = 2048, DIN = 6400, NLAYER = 4;
constexpr int ROWS_PROMPT = 16384;
constexpr float LN_EPS = 1e-5f;
constexpr float ALPHA = 1.681792830507429f;
constexpr float LOG2E = 1.4426950408889634f;
constexpr int C_AU = 0, C_AV = 512, C_AG = 1024, C_BA = 1536, C_BB = 2048, C_BG = 2560, C_Q = 3072, C_K = 3584, C_V = 3712, C_CG = 3840,
              C_DB = 4352, C_DC = 4864, C_DX = 5376, C_DG = 5888;
constexpr size_t WS_WIN = 0;
constexpr size_t WS_WOUT = WS_WIN + (size_t)NLAYER * DIN * DM * 2;
constexpr size_t WS_XB = WS_WOUT + (size_t)NLAYER * DM * DM * 2;
constexpr size_t WS_H = WS_XB + (size_t)MTOK * DM * 2;
constexpr size_t WS_SGUW = WS_H + (size_t)MTOK * DIN * 2;
constexpr size_t WS_END = WS_SGUW + (size_t)NLAYER * 4 * 128 * 128 * 2;
constexpr int LDS_BYTES = 136 * 1024;
constexpr int NPHASE = 1 + 4 * NLAYER;

struct P {
    const float *x_prompt, *x_sample, *w_in, *w_out, *sgu_ln_g, *sgu_ln_b, *sgu_w, *sgu_b, *cm_conv_w, *cm_conv_b, *cm_ln_g, *cm_ln_b, *attn_sink, *sc_conv_w, *post_ln_g, *post_ln_b;
    float* out; unsigned char* ws; int ph_lo, ph_hi;
};

__device__ __forceinline__ float bflo(unsigned w) { return __uint_as_float(w << 16); }
__device__ __forceinline__ float bfhi(unsigned w) { return __uint_as_float(w & 0xffff0000u); }
__device__ __forceinline__ float bf1(bf16_t b) { return __uint_as_float(((unsigned)b) << 16); }
__device__ __forceinline__ unsigned pk2(float lo, float hi) { return pg8::cvt_pk_bf16(lo, hi); }
__device__ __forceinline__ void unpack8(const u32x4 r, float (&v)[8]) {
    v[0] = bflo(r.x); v[1] = bfhi(r.x); v[2] = bflo(r.y); v[3] = bfhi(r.y); v[4] = bflo(r.z); v[5] = bfhi(r.z); v[6] = bflo(r.w); v[7] = bfhi(r.w); }
__device__ __forceinline__ u32x4 pack8(const float (&v)[8]) { u32x4 w; w.x = pk2(v[0], v[1]); w.y = pk2(v[2], v[3]); w.z = pk2(v[4], v[5]); w.w = pk2(v[6], v[7]); return w; }
__device__ __forceinline__ float ex2(float x) { return __builtin_amdgcn_exp2f(x); }
__device__ __forceinline__ float sigm_f(float x) { return __builtin_amdgcn_rcpf(1.0f + ex2(-x * LOG2E)); }
__device__ __forceinline__ float silu_f(float x) { return x * sigm_f(x); }
__device__ __forceinline__ float wave_sum(float v) { v += __shfl_xor(v, 32); v += __shfl_xor(v, 16); v += __shfl_xor(v, 8); v += __shfl_xor(v, 4); v += __shfl_xor(v, 2); v += __shfl_xor(v, 1); return v; }
__device__ __forceinline__ void seq_of_row(int row0, int& pos0, int& S) { if (row0 < ROWS_PROMPT) { S = 2048; pos0 = row0 & 2047; } else { S = 4096; pos0 = (row0 - ROWS_PROMPT) & 4095; } }

struct EpiResid {
    static constexpr bool PERM = false, AFTER_DRAIN = false;
    const float* xp; const float* xs; float* out; int layer0;
    __device__ __forceinline__ void operator()(const f32x4 (&acc)[2][2][4][2], const pg8::Unit& u, int wr, int wc, int fr, int fq) const {
        const int row0 = u.pm * 256 + wr * 64 + fr, col0 = u.pn * 256 + wc * 32 + 4 * fq;
#pragma unroll
        for (int ai = 0; ai < 2; ++ai)
#pragma unroll
            for (int m = 0; m < 4; ++m) {
                const int row = row0 + ai * 128 + m * 16;
                const size_t off = (size_t)row * DM + col0;
                const float* src = layer0 ? (row < ROWS_PROMPT ? xp + off : xs + (off - (size_t)ROWS_PROMPT * DM)) : (const float*)out + off;
                float* dst = out + off;
#pragma unroll
                for (int bj = 0; bj < 2; ++bj)
#pragma unroll
                    for (int n = 0; n < 2; ++n) { const f32x4 xv = *(const f32x4*)(src + bj * 128 + n * 16); *(f32x4*)(dst + bj * 128 + n * 16) = xv * ALPHA + acc[ai][bj][m][n]; }
                asm volatile("" ::: "memory");
            }
    }
};

__device__ __forceinline__ void phase_prep(const P& p, LAS unsigned char* lds) {
    int tid = threadIdx.x; asm volatile("" : "+v"(tid)); const int G = gridDim.x, b = blockIdx.x;
    LAS float* tile = (LAS float*)lds;
    bf16_t* WinT = (bf16_t*)(p.ws + WS_WIN); bf16_t* WoutT = (bf16_t*)(p.ws + WS_WOUT);
    for (int t = b; t < 16896; t += G) {
        const float* src; bf16_t* dst; int N, kt, ntl;
        if (t < 12800) { const int l = t / 3200, r = t % 3200; kt = r / 100; ntl = r % 100; N = DIN; src = p.w_in + (size_t)l * DM * DIN; dst = WinT + (size_t)l * DIN * DM; }
        else { const int tt = t - 12800; const int l = tt / 1024, r = tt % 1024; kt = r / 32; ntl = r % 32; N = DM; src = p.w_out + (size_t)l * DM * DM; dst = WoutT + (size_t)l * DM * DM; }
        const int k0 = kt * 64, n0 = ntl * 64;
#pragma unroll
        for (int pass = 0; pass < 2; ++pass) { const int row = (tid >> 4) + 32 * pass, c4 = tid & 15;
            const f32x4 v = *(const f32x4*)(src + (size_t)(k0 + row) * N + n0 + 4 * c4);
            tile[row * 65 + 4 * c4 + 0] = v[0]; tile[row * 65 + 4 * c4 + 1] = v[1]; tile[row * 65 + 4 * c4 + 2] = v[2]; tile[row * 65 + 4 * c4 + 3] = v[3]; }
        __syncthreads();
        { const int n = tid >> 3, k8 = tid & 7; float f[8];
#pragma unroll
            for (int j = 0; j < 8; ++j) f[j] = tile[(8 * k8 + j) * 65 + n];
            *(u32x4*)(dst + (size_t)(n0 + n) * DM + k0 + 8 * k8) = pack8(f); }
        __syncthreads();
    }
    bf16_t* XB = (bf16_t*)(p.ws + WS_XB);
    for (size_t c = (size_t)b * 512 + tid; c < (size_t)MTOK * DM / 8; c += (size_t)G * 512) {
        const size_t e = c * 8; const float* s = e < (size_t)ROWS_PROMPT * DM ? p.x_prompt + e : p.x_sample + (e - (size_t)ROWS_PROMPT * DM);
        const f32x4 a = *(const f32x4*)s, bq = *(const f32x4*)(s + 4); u32x4 w; w.x = pk2(a[0], a[1]); w.y = pk2(a[2], a[3]); w.z = pk2(bq[0], bq[1]); w.w = pk2(bq[2], bq[3]);
        *(u32x4*)(XB + e) = w; }
    bf16_t* SW = (bf16_t*)(p.ws + WS_SGUW);
    for (int c = b * 512 + tid; c < NLAYER * 4 * 128 * 128 / 8; c += G * 512) {
        const float* s = p.sgu_w + (size_t)c * 8; const f32x4 a = *(const f32x4*)s, bq = *(const f32x4*)(s + 4); u32x4 w; w.x = pk2(a[0], a[1]); w.y = pk2(a[2], a[3]); w.z = pk2(bq[0], bq[1]); w.w = pk2(bq[2], bq[3]);
        *(u32x4*)(SW + (size_t)c * 8) = w; }
}

constexpr int VN_PITCH = 520;
__device__ __forceinline__ void mixer_sgu(const P& p, int l, int row0, LAS unsigned char* lds) {
    int tid = threadIdx.x; asm volatile("" : "+v"(tid)); const int wave = tid >> 6, lane = tid & 63;
    const bf16_t* H = (const bf16_t*)(p.ws + WS_H); bf16_t* Y = (bf16_t*)(p.ws + WS_XB);
    LAS bf16_t* vn = (LAS bf16_t*)lds;
    {
        float gg[8], bb[8];
        { const f32x4 g0 = *(const f32x4*)(p.sgu_ln_g + l * 512 + 8 * lane), g1 = *(const f32x4*)(p.sgu_ln_g + l * 512 + 8 * lane + 4);
          const f32x4 b0 = *(const f32x4*)(p.sgu_ln_b + l * 512 + 8 * lane), b1 = *(const f32x4*)(p.sgu_ln_b + l * 512 + 8 * lane + 4);
#pragma unroll
          for (int j = 0; j < 4; ++j) { gg[j] = g0[j]; gg[4 + j] = g1[j]; bb[j] = b0[j]; bb[4 + j] = b1[j]; } }
#pragma unroll 4
        for (int i = 0; i < 16; ++i) { const int s = wave * 16 + i;
            const u32x4 raw = *(const u32x4*)(H + (size_t)(row0 + s) * DIN + C_AV + 8 * lane);
            float v[8]; unpack8(raw, v);
            float sum = 0.f;
#pragma unroll
            for (int j = 0; j < 8; ++j) sum += v[j];
            const float mean = wave_sum(sum) * (1.0f / 512.0f);
            float q = 0.f;
#pragma unroll
            for (int j = 0; j < 8; ++j) { v[j] -= mean; q += v[j] * v[j]; }
            const float rstd = rsqrtf(wave_sum(q) * (1.0f / 512.0f) + LN_EPS);
#pragma unroll
            for (int j = 0; j < 8; ++j) v[j] = v[j] * rstd * gg[j] + bb[j];
            *(LAS u32x4*)(vn + s * VN_PITCH + 8 * lane) = pack8(v); }
    }
    __syncthreads();
    {
        const int hd = wave >> 1, th = wave & 1, r = lane & 15, q = lane >> 4, qq = (lane >> 2) & 3, pp = lane & 3;
        const bf16_t* W = (const bf16_t*)(p.ws + WS_SGUW) + (size_t)(l * 4 + hd) * 128 * 128;
#pragma unroll 1
        for (int dh = 0; dh < 2; ++dh) {
        f32x4 acc[4][4];
#pragma unroll
        for (int a = 0; a < 4; ++a)
#pragma unroll
            for (int c = 0; c < 4; ++c) acc[a][c] = (f32x4){0.f, 0.f, 0.f, 0.f};
#pragma unroll
        for (int ks = 0; ks < 4; ++ks) {
            bf16x8 wf[4];
#pragma unroll
            for (int tt = 0; tt < 4; ++tt) wf[tt] = *(const bf16x8*)(W + (size_t)(64 * th + 16 * tt + r) * 128 + 32 * ks + 8 * q);
#pragma unroll
            for (int dt = 0; dt < 4; ++dt) {
                const LAS bf16_t* ap = vn + (32 * ks + 8 * q + qq) * VN_PITCH + 128 * hd + 64 * dh + 16 * dt + 4 * pp;
                const s16x4 lo = __builtin_amdgcn_ds_read_tr16_b64_v4i16((LAS s16x4*)ap);
                const s16x4 hi = __builtin_amdgcn_ds_read_tr16_b64_v4i16((LAS s16x4*)(ap + 4 * VN_PITCH));
                const bf16x8 af = {lo[0], lo[1], lo[2], lo[3], hi[0], hi[1], hi[2], hi[3]};
#pragma unroll
                for (int tt = 0; tt < 4; ++tt) acc[dt][tt] = __builtin_amdgcn_mfma_f32_16x16x32_bf16(af, wf[tt], acc[dt][tt], 0, 0, 0);
            }
        }
#pragma unroll
        for (int tt = 0; tt < 4; ++tt) { const int t = 64 * th + 16 * tt + r; const float bs = p.sgu_b[(l * 4 + hd) * 128 + t];
            const bf16_t* hrow = H + (size_t)(row0 + t) * DIN; bf16_t* yrow = Y + (size_t)(row0 + t) * DM;
#pragma unroll
            for (int dt = 0; dt < 4; ++dt) { const int d0 = 128 * hd + 64 * dh + 16 * dt + 4 * q;
                const u32x2 uu = *(const u32x2*)(hrow + C_AU + d0), ag = *(const u32x2*)(hrow + C_AG + d0);
                const f32x4 a = acc[dt][tt];
                const float o0 = bflo(uu.x) * (a[0] + bs) * silu_f(bflo(ag.x)), o1 = bfhi(uu.x) * (a[1] + bs) * silu_f(bfhi(ag.x));
                const float o2 = bflo(uu.y) * (a[2] + bs) * silu_f(bflo(ag.y)), o3 = bfhi(uu.y) * (a[3] + bs) * silu_f(bfhi(ag.y));
                u32x2 w; w.x = pk2(o0, o1); w.y = pk2(o2, o3); *(u32x2*)(yrow + d0) = w; } }
        }
    }
}

__device__ __forceinline__ void mixer_conf(const P& p, int l, int row0, int pos0, int S, LAS unsigned char* lds) {
    int tid = threadIdx.x; asm volatile("" : "+v"(tid)); const int wave = tid >> 6, lane = tid & 63;
    const bf16_t* H = (const bf16_t*)(p.ws + WS_H); bf16_t* Y = (bf16_t*)(p.ws + WS_XB);
    LAS float* gbuf = (LAS float*)lds;
    LAS float* cbuf = (LAS float*)(lds + 62 * 256 * 4);
    float lg[8], lb[8];
    { const f32x4 g0 = *(const f32x4*)(p.cm_ln_g + l * 512 + 8 * lane), g1 = *(const f32x4*)(p.cm_ln_g + l * 512 + 8 * lane + 4);
      const f32x4 b0 = *(const f32x4*)(p.cm_ln_b + l * 512 + 8 * lane), b1 = *(const f32x4*)(p.cm_ln_b + l * 512 + 8 * lane + 4);
#pragma unroll
      for (int j = 0; j < 4; ++j) { lg[j] = g0[j]; lg[4 + j] = g1[j]; lb[j] = b0[j]; lb[4 + j] = b1[j]; } }
#pragma unroll 1
    for (int sub = 0; sub < 4; ++sub) { const int t0 = 32 * sub;
#pragma unroll 1
        for (int ch = 0; ch < 2; ++ch) {
#pragma unroll
            for (int it = 0; it < 4; ++it) { const int i = tid + 512 * it;
                if (i < 62 * 32) { const int ri = i >> 5, c8 = i & 31; const int t = t0 - 15 + ri; const int pos = pos0 + t;
                    float gv[8];
                    if (pos >= 0 && pos < S) { const bf16_t* hr = H + (size_t)(row0 + t) * DIN + 256 * ch + 8 * c8;
                        const u32x4 ra = *(const u32x4*)(hr + C_BA), rb = *(const u32x4*)(hr + C_BB); float a[8], bq[8]; unpack8(ra, a); unpack8(rb, bq);
#pragma unroll
                        for (int j = 0; j < 8; ++j) gv[j] = a[j] * sigm_f(bq[j]); }
                    else {
#pragma unroll
                        for (int j = 0; j < 8; ++j) gv[j] = 0.f; }
                    *(LAS f32x4*)(gbuf + ri * 256 + 8 * c8) = (f32x4){gv[0], gv[1], gv[2], gv[3]}; *(LAS f32x4*)(gbuf + ri * 256 + 8 * c8 + 4) = (f32x4){gv[4], gv[5], gv[6], gv[7]}; } }
            __syncthreads();
            { const int c = tid & 255, tg = tid >> 8, chn = 256 * ch + c;
                float w[31];
#pragma unroll
                for (int j = 0; j < 31; ++j) w[j] = p.cm_conv_w[(size_t)(l * 31 + j) * 512 + chn];
                const float bias = p.cm_conv_b[l * 512 + chn];
                float acc[16];
#pragma unroll
                for (int tt = 0; tt < 16; ++tt) acc[tt] = bias;
#pragma unroll
                for (int i = 0; i < 46; ++i) { const float val = gbuf[(16 * tg + i) * 256 + c];
#pragma unroll
                    for (int tt = 0; tt < 16; ++tt) { const int j = i - tt; if (j >= 0 && j < 31) acc[tt] += w[j] * val; } }
#pragma unroll
                for (int tt = 0; tt < 16; ++tt) cbuf[(16 * tg + tt) * 512 + chn] = acc[tt]; }
            __syncthreads();
        }
#pragma unroll
        for (int i = 0; i < 4; ++i) { const int tk = 4 * wave + i;
            const f32x4 c0 = *(const LAS f32x4*)(cbuf + tk * 512 + 8 * lane), c1 = *(const LAS f32x4*)(cbuf + tk * 512 + 8 * lane + 4);
            float v[8] = {c0[0], c0[1], c0[2], c0[3], c1[0], c1[1], c1[2], c1[3]};
            float sum = 0.f;
#pragma unroll
            for (int j = 0; j < 8; ++j) sum += v[j];
            const float mean = wave_sum(sum) * (1.0f / 512.0f);
            float q = 0.f;
#pragma unroll
            for (int j = 0; j < 8; ++j) { v[j] -= mean; q += v[j] * v[j]; }
            const float rstd = rsqrtf(wave_sum(q) * (1.0f / 512.0f) + LN_EPS);
            const size_t row = (size_t)(row0 + t0 + tk);
            const u32x4 rg = *(const u32x4*)(H + row * DIN + C_BG + 8 * lane); float gt[8]; unpack8(rg, gt);
#pragma unroll
            for (int j = 0; j < 8; ++j) { const float yv = v[j] * rstd * lg[j] + lb[j]; v[j] = silu_f(yv) * silu_f(gt[j]); }
            *(u32x4*)(Y + row * DM + 512 + 8 * lane) = pack8(v); }
    }
}

constexpr int KP = 72, VP = 80, NKT = 18;
__device__ __forceinline__ void mixer_attn(const P& p, int l, int row0, int pos0, int S, LAS unsigned char* lds) {
    int tid = threadIdx.x; asm volatile("" : "+v"(tid)); const int wave = tid >> 6, lane = tid & 63;
    const bf16_t* H = (const bf16_t*)(p.ws + WS_H); bf16_t* Y = (bf16_t*)(p.ws + WS_XB);
    LAS bf16_t* Kb = (LAS bf16_t*)lds;
    LAS bf16_t* Vb = (LAS bf16_t*)(lds + 384 * KP * 2);
    const int rq = lane & 15, q4 = lane >> 4, qq = (lane >> 2) & 3, pp = lane & 3;
#pragma unroll 1
    for (int g = 0; g < 2; ++g) {
        __syncthreads();
#pragma unroll 2
        for (int it = 0; it < 6; ++it) { const int i = tid + 512 * it; const int kk = i >> 3, c8 = i & 7; const int pos = pos0 - 128 + kk;
            u32x4 kv = (u32x4){0u, 0u, 0u, 0u}, vv = (u32x4){0u, 0u, 0u, 0u};
            if (pos >= 0 && pos < S) { const bf16_t* hr = H + (size_t)((long)row0 - 128 + kk) * DIN + 64 * g + 8 * c8; kv = *(const u32x4*)(hr + C_K); vv = *(const u32x4*)(hr + C_V); }
            *(LAS u32x4*)(Kb + kk * KP + 8 * c8) = kv; *(LAS u32x4*)(Vb + kk * VP + 8 * c8) = vv; }
        __syncthreads();
        const int head = 4 * g + (wave >> 1), qh = wave & 1;
        const float slope2 = ex2(-(float)(head + 1)) * LOG2E;
        const float sink2 = p.attn_sink[l * 8 + head] * LOG2E;
#pragma unroll 1
        for (int pass = 0; pass < 4; ++pass) { const int q0 = 64 * qh + 16 * pass;
            bf16x8 Qf[2];
            { const bf16_t* qp = H + (size_t)(row0 + q0 + rq) * DIN + C_Q + 64 * head + 8 * q4; Qf[0] = *(const bf16x8*)qp; Qf[1] = *(const bf16x8*)(qp + 32); }
            int t0k = q0 >> 4; if (t0k > 6) t0k = 6;
            const int kb0 = 16 * t0k;
            f32x4 sacc[NKT];
            const LAS bf16_t* kbase = Kb + (kb0 + rq) * KP + 8 * q4;
#pragma unroll
            for (int kt = 0; kt < NKT; ++kt) { const LAS bf16_t* kp = kbase + kt * (16 * KP);
                const bf16x8 k0 = *(const LAS bf16x8*)kp, k1 = *(const LAS bf16x8*)(kp + 32);
                f32x4 a = (f32x4){0.f, 0.f, 0.f, 0.f};
                a = __builtin_amdgcn_mfma_f32_16x16x32_bf16(k0, Qf[0], a, 0, 0, 0); a = __builtin_amdgcn_mfma_f32_16x16x32_bf16(k1, Qf[1], a, 0, 0, 0); sacc[kt] = a; }
            const int basei = 128 + q0 + rq - kb0 - 4 * q4;
            const int loi = -(pos0 - 128 + kb0 + 4 * q4), hii = loi + S - 1;
            const int cmin_i = max(loi, basei - 128), cmax_i = min(hii, basei + 128);
            const float basef = (float)basei, cminf = (float)cmin_i, cmaxf = (float)cmax_i;
            float mx = -3.0e38f;
#pragma unroll
            for (int kt = 0; kt < NKT; ++kt)
#pragma unroll
                for (int jj = 0; jj < 4; ++jj) { const float c = (float)(16 * kt + jj); const float dist = fabsf(basef - c);
                    const bool valid = (c >= cminf) && (c <= cmaxf);
                    const float sc = valid ? sacc[kt][jj] * (0.125f * LOG2E) - slope2 * dist : -1.0e30f;
                    sacc[kt][jj] = sc; mx = fmaxf(mx, sc); }
            mx = fmaxf(mx, __shfl_xor(mx, 16)); mx = fmaxf(mx, __shfl_xor(mx, 32));
            const float m2 = fmaxf(mx, sink2);
            float sum = 0.f;
#pragma unroll
            for (int kt = 0; kt < NKT; ++kt)
#pragma unroll
                for (int jj = 0; jj < 4; ++jj) { const float e = ex2(sacc[kt][jj] - m2); sacc[kt][jj] = e; sum += e; }
            sum += __shfl_xor(sum, 16); sum += __shfl_xor(sum, 32);
            const float inv = 1.0f / (sum + ex2(sink2 - m2));
            f32x4 o[4];
#pragma unroll
            for (int dt = 0; dt < 4; ++dt) o[dt] = (f32x4){0.f, 0.f, 0.f, 0.f};
            const LAS bf16_t* vbase = Vb + (kb0 + 4 * q4 + qq) * VP + 4 * pp;
#pragma unroll
            for (int s = 0; s < NKT / 2; ++s) {
                const f32x4 e0 = sacc[2 * s] * inv, e1 = sacc[2 * s + 1] * inv;
                u32x4 pw; pw.x = pk2(e0[0], e0[1]); pw.y = pk2(e0[2], e0[3]); pw.z = pk2(e1[0], e1[1]); pw.w = pk2(e1[2], e1[3]);
                const bf16x8 pf = __builtin_bit_cast(bf16x8, pw);
#pragma unroll
                for (int dt = 0; dt < 4; ++dt) { const LAS bf16_t* vp = vbase + s * (32 * VP) + 16 * dt;
                    const s16x4 lo = __builtin_amdgcn_ds_read_tr16_b64_v4i16((LAS s16x4*)vp);
                    const s16x4 hi = __builtin_amdgcn_ds_read_tr16_b64_v4i16((LAS s16x4*)(vp + 16 * VP));
                    const bf16x8 vf = {lo[0], lo[1], lo[2], lo[3], hi[0], hi[1], hi[2], hi[3]};
                    o[dt] = __builtin_amdgcn_mfma_f32_16x16x32_bf16(pf, vf, o[dt], 0, 0, 0); }
            }
#pragma unroll
            for (int jj = 0; jj < 4; ++jj) { const size_t row = (size_t)(row0 + q0 + 4 * q4 + jj);
#pragma unroll
                for (int dt = 0; dt < 4; ++dt) { const int chn = 64 * head + 16 * dt + rq;
                    const float gate = bf1(H[row * DIN + C_CG + chn]);
                    Y[row * DM + 1024 + chn] = (bf16_t)(pk2(o[dt][jj] * silu_f(gate), 0.f) & 0xffffu); } }
        }
    }
}

#define SC_LOADP(dst, t_) do { const int _t = (t_); const int _pos = pos0 + _t; \
        if (_pos >= 0 && _pos < S) { const bf16_t* _hr = H + (size_t)((long)row0 + _t) * DIN + c0; const u32x4 _rc = *(const u32x4*)(_hr + C_DC), _rx = *(const u32x4*)(_hr + C_DX); float _c[8], _x[8]; unpack8(_rc, _c); unpack8(_rx, _x); \
            _Pragma("unroll") for (int _j = 0; _j < 8; ++_j) dst[_j] = _c[_j] * _x[_j]; } \
        else { _Pragma("unroll") for (int _j = 0; _j < 8; ++_j) dst[_j] = 0.f; } } while (0)
__device__ __forceinline__ void mixer_sconv(const P& p, int l, int row0, int pos0, int S) {
    int tid = threadIdx.x; asm volatile("" : "+v"(tid)); const int wave = tid >> 6, lane = tid & 63, c0 = 8 * lane;
    const bf16_t* H = (const bf16_t*)(p.ws + WS_H); bf16_t* Y = (bf16_t*)(p.ws + WS_XB);
    float w0[8], w1[8], w2[8];
    { const float* wp = p.sc_conv_w + (size_t)l * 3 * 512 + c0;
#pragma unroll
      for (int j = 0; j < 8; ++j) { w0[j] = wp[j]; w1[j] = wp[512 + j]; w2[j] = wp[1024 + j]; } }
    const int tb = 16 * wave;
    float prev[8], cur[8], nxt[8];
    SC_LOADP(prev, tb - 1); SC_LOADP(cur, tb);
#pragma unroll 4
    for (int i = 0; i < 16; ++i) { const int t = tb + i;
        SC_LOADP(nxt, t + 1);
        const bf16_t* hr = H + (size_t)(row0 + t) * DIN + c0;
        const u32x4 rb = *(const u32x4*)(hr + C_DB), rg = *(const u32x4*)(hr + C_DG); float bv[8], gv[8]; unpack8(rb, bv); unpack8(rg, gv);
        float o[8];
#pragma unroll
        for (int j = 0; j < 8; ++j) { const float cv = w0[j] * prev[j] + w1[j] * cur[j] + w2[j] * nxt[j]; o[j] = bv[j] * cv * silu_f(gv[j]); prev[j] = cur[j]; cur[j] = nxt[j]; }
        *(u32x4*)(Y + (size_t)(row0 + t) * DM + 1536 + c0) = pack8(o); }
}

__device__ __forceinline__ void phase_mixers(const P& p, int l, LAS unsigned char* lds) {
    for (int blk = blockIdx.x; blk < MTOK / 128; blk += gridDim.x) {
        const int row0 = blk * 128; int pos0, S; seq_of_row(row0, pos0, S);
        __syncthreads();
#ifndef NO_SGU
        mixer_sgu(p, l, row0, lds);
#endif
        __syncthreads();
#ifndef NO_CONF
        mixer_conf(p, l, row0, pos0, S, lds);
#endif
#ifndef NO_ATTN
        mixer_attn(p, l, row0, pos0, S, lds);
#endif
#ifndef NO_SCONV
        mixer_sconv(p, l, row0, pos0, S);
#endif
    }
}

__device__ __forceinline__ void phase_ln(const P& p, int l) {
    int tid = threadIdx.x; asm volatile("" : "+v"(tid)); const int wave = tid >> 6, lane = tid & 63;
    bf16_t* XB = (bf16_t*)(p.ws + WS_XB);
    f32x4 gg[8], bb[8];
#pragma unroll
    for (int j = 0; j < 8; ++j) { gg[j] = *(const f32x4*)(p.post_ln_g + l * DM + 4 * lane + 256 * j); bb[j] = *(const f32x4*)(p.post_ln_b + l * DM + 4 * lane + 256 * j); }
    const bool last = (l == NLAYER - 1);
    for (int row = blockIdx.x * 8 + wave; row < MTOK; row += gridDim.x * 8) {
        float* zr = p.out + (size_t)row * DM + 4 * lane;
        f32x4 v[8]; float sum = 0.f;
#pragma unroll
        for (int j = 0; j < 8; ++j) { v[j] = *(const f32x4*)(zr + 256 * j); sum += (v[j][0] + v[j][1]) + (v[j][2] + v[j][3]); }
        const float mean = wave_sum(sum) * (1.0f / DM);
        float q = 0.f;
#pragma unroll
        for (int j = 0; j < 8; ++j) { v[j] -= mean; q += (v[j][0] * v[j][0] + v[j][1] * v[j][1]) + (v[j][2] * v[j][2] + v[j][3] * v[j][3]); }
        const float rstd = rsqrtf(wave_sum(q) * (1.0f / DM) + LN_EPS);
#pragma unroll
        for (int j = 0; j < 8; ++j) { const f32x4 x = v[j] * rstd * gg[j] + bb[j]; *(f32x4*)(zr + 256 * j) = x;
            if (!last) { u32x2 w; w.x = pk2(x[0], x[1]); w.y = pk2(x[2], x[3]); *(u32x2*)(XB + (size_t)row * DM + 4 * lane + 256 * j) = w; } }
    }
}

__global__ void __launch_bounds__(512, 2) mega(P p) {
    extern __shared__ __attribute__((aligned(16))) unsigned char smem[];
    LAS unsigned char* lds = (LAS unsigned char*)smem;
    cg::grid_group grid = cg::this_grid();
#define RUN(k) (p.ph_lo <= (k) && (k) < p.ph_hi)
#define SEAM(k) do { if (MK_COOP && RUN(k) && RUN((k) + 1)) grid.sync(); } while (0)
#ifndef NO_PREP
    if (RUN(0)) { phase_prep(p, lds); SEAM(0); }
#endif
#pragma unroll 1
    for (int l = 0; l < NLAYER; ++l) {
        const int k = 1 + 4 * l;
        if (RUN(k)) {
            pg8::Gemm g{(const bf16_t*)(p.ws + WS_XB), (const bf16_t*)(p.ws + WS_WIN) + (size_t)l * DIN * DM, MTOK, DIN, DM};
            pg8::StaticOrder So; So.init(MTOK, DIN, gridDim.x, blockIdx.x);
            pg8::EpiBf16<0> E{(bf16_t*)(p.ws + WS_H), DIN, nullptr, 0, 0};
            __syncthreads();
#ifndef NO_G1
            pg8::gemm_phase<pg8::EpiBf16<0>, pg8::StaticOrder, false>(lds, g, So, E, nullptr);
#endif
            SEAM(k);
        }
        if (RUN(k + 1)) { phase_mixers(p, l, lds); SEAM(k + 1); }
        if (RUN(k + 2)) {
            pg8::Gemm g{(const bf16_t*)(p.ws + WS_XB), (const bf16_t*)(p.ws + WS_WOUT) + (size_t)l * DM * DM, MTOK, DM, DM};
            pg8::StaticOrder So; So.init(MTOK, DM, gridDim.x, blockIdx.x);
            EpiResid E{p.x_prompt, p.x_sample, p.out, l == 0 ? 1 : 0};
            __syncthreads();
#ifndef NO_G2
            pg8::gemm_phase<EpiResid, pg8::StaticOrder, false>(lds, g, So, E, nullptr);
#endif
            SEAM(k + 2);
        }
#ifndef NO_LN
        if (RUN(k + 3)) { phase_ln(p, l); SEAM(k + 3); }
#endif
    }
#undef RUN
#undef SEAM
}

extern "C" void kernel_launch(void* const* d_in, const int* in_sizes, int n_in, void* d_out, int out_size, void* d_ws, size_t ws_size, hipStream_t stream) {
    static int grid_blocks = 0;
    if (grid_blocks == 0) {
        if (n_in != 16 || out_size != MTOK * DM || ws_size < WS_END) { fprintf(stderr, "kernel_launch: unexpected shapes (n_in %d out %d ws %zu need %zu)\n", n_in, out_size, ws_size, (size_t)WS_END); grid_blocks = -1; return; }
        int dev = 0, cus = 0, per_cu = 0;
        (void)hipGetDevice(&dev); (void)hipDeviceGetAttribute(&cus, hipDeviceAttributeMultiprocessorCount, dev);
        if (hipFuncSetAttribute((const void*)mega, hipFuncAttributeMaxDynamicSharedMemorySize, LDS_BYTES) != hipSuccess) { fprintf(stderr, "kernel_launch: hipFuncSetAttribute failed\n"); grid_blocks = -1; return; }
        if (hipOccupancyMaxActiveBlocksPerMultiprocessor(&per_cu, (const void*)mega, 512, LDS_BYTES) != hipSuccess || per_cu < 1) per_cu = 1;
        (void)hipGetLastError();
        if (cus <= 0) cus = 256;
        grid_blocks = cus * per_cu;
    }
    if (grid_blocks < 0) return;
    P p{};
    p.x_prompt = (const float*)d_in[0]; p.x_sample = (const float*)d_in[1]; p.w_in = (const float*)d_in[2]; p.w_out = (const float*)d_in[3];
    p.sgu_ln_g = (const float*)d_in[4]; p.sgu_ln_b = (const float*)d_in[5]; p.sgu_w = (const float*)d_in[6]; p.sgu_b = (const float*)d_in[7];
    p.cm_conv_w = (const float*)d_in[8]; p.cm_conv_b = (const float*)d_in[9]; p.cm_ln_g = (const float*)d_in[10]; p.cm_ln_b = (const float*)d_in[11];
    p.attn_sink = (const float*)d_in[12]; p.sc_conv_w = (const float*)d_in[13]; p.post_ln_g = (const float*)d_in[14]; p.post_ln_b = (const float*)d_in[15];
    p.out = (float*)d_out; p.ws = (unsigned char*)d_ws;
#if MK_COOP
    p.ph_lo = 0; p.ph_hi = NPHASE;
    void* args[] = {&p};
    hipError_t e = hipLaunchCooperativeKernel((const void*)mega, dim3(grid_blocks), dim3(512), args, LDS_BYTES, stream);
    if (e != hipSuccess) fprintf(stderr, "cooperative launch failed: %s (grid %d)\n", hipGetErrorString(e), grid_blocks);
#else
    for (int k = 0; k < NPHASE; ++k) { p.ph_lo = k; p.ph_hi = k + 1; hipLaunchKernelGGL(mega, dim3(grid_blocks), dim3(512), LDS_BYTES, stream, p); }
#endif
}
```

```cpp
#include <hip/hip_runtime.h>
#include <hip/hip_cooperative_groups.h>
#include <cstdio>
namespace cg = cooperative_groups;
namespace pg8 {
#define PG8_LAS __attribute__((address_space(3)))
typedef unsigned short bf16_t;
typedef short bf16x8 __attribute__((ext_vector_type(8)));
typedef float f32x4 __attribute__((ext_vector_type(4)));
typedef unsigned u32x4 __attribute__((ext_vector_type(4)));
constexpr int BM = 256, BK = 64, HALF = 128, HTB = HALF * BK * 2  , STAGE_BYTES = 8 * HTB, NXCD = 8, WGM = 8;

__host__ __device__ __forceinline__ int lds_byte(int r, int c) { const int st = (r >> 4) * 2 + (c >> 5), rr = r & 15, cc = c & 31, ob = rr * 64 + cc * 2; return st * 1024 + (ob ^ (((ob >> 9) & 1) << 5)); }
__host__ __device__ __forceinline__ void stage_rc(int b, int& R, int& C) { const int st = b / 1024, sb = b % 1024, swz = sb ^ (((sb >> 9) & 1) << 5); R = (st >> 1) * 16 + swz / 64; C = (st & 1) * 32 + (swz % 64) / 2; }
__host__ __device__ __forceinline__ int perm32(int rho) { const int n = rho >> 4, i = rho & 15; return 8 * (i >> 2) + 4 * n + (i & 3); }

struct Unit { int pm, pn; };
struct Gemm { const bf16_t* A; const bf16_t* Bt; int M, N, K; const bf16_t* A2; const bf16_t* B2; int nte; };

struct StaticOrder {
    int nM, nN, nwg, G, c;
    __host__ __device__ void init(int M, int N, int G_, int c_) { nM = M / BM; nN = N / BM; nwg = nM * nN; G = G_; c = c_; }
    __host__ __device__ bool next(int i, Unit& u) const {
        const long L = (long)i * G + c; if (L >= nwg) return false;
        int wgid = (int)L; { const int q = nwg / NXCD, r = nwg % NXCD, xcd = wgid % NXCD, off = wgid / NXCD; wgid = (xcd < r ? xcd * (q + 1) : r * (q + 1) + (xcd - r) * q) + off; }
        const int nig = WGM * nN, gid = wgid / nig, fm = gid * WGM, gsz = (nM - fm) < WGM ? (nM - fm) : WGM;
        u.pm = fm + ((wgid % nig) % gsz); u.pn = (wgid % nig) / gsz; return true;
    }
    __device__ __forceinline__ void a_ready(const Unit&) const {}
    __device__ __forceinline__ void done(const Unit&) const {}
};

__device__ __forceinline__ unsigned cvt_pk_bf16(float lo, float hi) { unsigned r; asm("v_cvt_pk_bf16_f32 %0, %1, %2" : "=v"(r) : "v"(lo), "v"(hi)); return r; }
typedef float f32x2 __attribute__((ext_vector_type(2)));
__device__ __forceinline__ f32x2 gelu_pk(f32x2 v) {
    const f32x2 av = __builtin_elementwise_abs(v), d = av * 0.2316418882f + 1.0f;
    f32x2 t; t.x = __builtin_amdgcn_rcpf(d.x); t.y = __builtin_amdgcn_rcpf(d.y);
    f32x2 q = t * 0.5307027145f + (-0.7265760135f); q = q * t + 0.7107068705f; q = q * t + (-0.142248368f); q = q * t + 0.127414796f; q = q * t;
    const f32x2 s = (v * v) * (-0.72134752044f);
    f32x2 e; e.x = __builtin_amdgcn_exp2f(s.x); e.y = __builtin_amdgcn_exp2f(s.y);
    const f32x2 m = v * (q * e), r = v - m;
    f32x2 o; o.x = v.x < 0.f ? m.x : r.x; o.y = v.y < 0.f ? m.y : r.y; return o;
}

struct EpiF32 {
    static constexpr bool PERM = false, AFTER_DRAIN = false;
    float* C; int ldc; const float* bias;
    __device__ __forceinline__ void operator()(const f32x4 (&acc)[2][2][4][2], const Unit& u, int wr, int wc, int fr, int fq) const {
        const int row0 = u.pm * BM + wr * 64 + fr, col0 = u.pn * BM + wc * 32 + 4 * fq;
        f32x4 bv[2][2];
#pragma unroll
        for (int bj = 0; bj < 2; ++bj)
#pragma unroll
            for (int n = 0; n < 2; ++n) bv[bj][n] = bias ? *(const f32x4*)(bias + col0 + bj * HALF + n * 16) : (f32x4){0.f, 0.f, 0.f, 0.f};
#pragma unroll
        for (int ai = 0; ai < 2; ++ai)
#pragma unroll
            for (int m = 0; m < 4; ++m) { float* rowp = C + (size_t)(row0 + ai * HALF + m * 16) * ldc + col0;
#pragma unroll
                for (int bj = 0; bj < 2; ++bj)
#pragma unroll
                    for (int n = 0; n < 2; ++n) *(f32x4*)(rowp + bj * HALF + n * 16) = acc[ai][bj][m][n] + bv[bj][n]; }
    }
};
template <int ACT  > struct EpiBf16 {
    static constexpr bool PERM = true, AFTER_DRAIN = false;
    bf16_t* O; int ldc; const float* bias; int split_cols; size_t split_stride;
    __device__ __forceinline__ void operator()(const f32x4 (&acc)[2][2][4][2], const Unit& u, int wr, int wc, int fr, int fq) const {
        const int row0 = u.pm * BM + wr * 64 + fr; int colt = u.pn * BM; bf16_t* base = O;
        if (split_cols) { const int t = colt / split_cols; base += (size_t)t * split_stride; colt -= t * split_cols; }
        const int col0 = colt + wc * 32 + 8 * fq, bcol0 = u.pn * BM + wc * 32 + 8 * fq;
        f32x4 bv[2][2];
#pragma unroll
        for (int bj = 0; bj < 2; ++bj)
#pragma unroll
            for (int n = 0; n < 2; ++n) bv[bj][n] = bias ? *(const f32x4*)(bias + bcol0 + bj * HALF + 4 * n) : (f32x4){0.f, 0.f, 0.f, 0.f};
#pragma unroll
        for (int ai = 0; ai < 2; ++ai)
#pragma unroll
            for (int m = 0; m < 4; ++m) { bf16_t* rowp = base + (size_t)(row0 + ai * HALF + m * 16) * ldc + col0;
#pragma unroll
                for (int bj = 0; bj < 2; ++bj) { f32x4 v0 = acc[ai][bj][m][0] + bv[bj][0], v1 = acc[ai][bj][m][1] + bv[bj][1];
                    if (ACT == 1) { f32x2 a = gelu_pk((f32x2){v0[0], v0[1]}), b = gelu_pk((f32x2){v0[2], v0[3]}), c = gelu_pk((f32x2){v1[0], v1[1]}), d = gelu_pk((f32x2){v1[2], v1[3]});
                        v0 = (f32x4){a.x, a.y, b.x, b.y}; v1 = (f32x4){c.x, c.y, d.x, d.y}; }
                    if (ACT == 2) {
#pragma unroll
                        for (int j = 0; j < 4; ++j) { v0[j] = 0.5f * v0[j] * (1.0f + erff(v0[j] * 0.70710678f)); v1[j] = 0.5f * v1[j] * (1.0f + erff(v1[j] * 0.70710678f)); } }
                    u32x4 w; w.x = cvt_pk_bf16(v0[0], v0[1]); w.y = cvt_pk_bf16(v0[2], v0[3]); w.z = cvt_pk_bf16(v1[0], v1[1]); w.w = cvt_pk_bf16(v1[2], v1[3]);
                    *(u32x4*)(rowp + bj * HALF) = w; } }
    }
};

typedef _Float16 f16x8 __attribute__((ext_vector_type(8)));
template <bool F16> __device__ __forceinline__ f32x4 mma16(const bf16x8 a, const bf16x8 b, const f32x4 c) {
    if constexpr (F16) return __builtin_amdgcn_mfma_f32_16x16x32_f16(__builtin_bit_cast(f16x8, a), __builtin_bit_cast(f16x8, b), c, 0, 0, 0);
    else return __builtin_amdgcn_mfma_f32_16x16x32_bf16(a, b, c, 0, 0, 0);
}
template <class Epi, class Sched, bool STAMP = false>
__device__ __forceinline__ void gemm_phase(PG8_LAS unsigned char* lds, const Gemm g, const Sched& S, const Epi& E, unsigned long long* stamps) {
    int tid = threadIdx.x; asm volatile("" : "+v"(tid));
    const int wid = __builtin_amdgcn_readfirstlane(tid >> 6), lane = tid & 63, wr = wid >> 2, wc = wid & 3, fr = lane & 15, fq = lane >> 4;
    const int K = g.K, ntm = K / BK, nt = ntm + g.nte;
    int ts_lo = 0, ts_hi = 0, nts = 0; const unsigned long long rt_entry = STAMP ? (unsigned long long)wall_clock64() : 0ull;
#define PG8_STAMP() do { if (STAMP && wid == 0 && nts < 64) { const unsigned long long _c = (unsigned long long)clock64(); \
        ts_lo = (lane == nts) ? (int)(unsigned)_c : ts_lo; ts_hi = (lane == nts) ? (int)(unsigned)(_c >> 32) : ts_hi; ++nts; } } while (0)
    PG8_STAMP();
    unsigned voffA[2], voffB[2];
#pragma unroll
    for (int i = 0; i < 2; ++i) { int R, C; stage_rc(tid * 16 + i * 8192, R, C); const int Rb = Epi::PERM ? ((R & ~31) + perm32(R & 31)) : R;
        voffA[i] = (unsigned)(R * K + C) * 2u; voffB[i] = (unsigned)(Rb * K + C) * 2u; }
    const size_t kstep = (size_t)(BK * 2);
    const size_t hstep = (size_t)HALF * K * 2;
    const size_t tstep = 2 * hstep;
    const unsigned ldsw = (unsigned)wid * 1024u;
    const int aoff = lds_byte(wr * 64 + fr, fq * 8), boff = lds_byte(wc * 32 + fr, fq * 8);
#define PG8_SA(b, h) (((b) * 2 + (h)) * HTB)
#define PG8_SB(b, h) ((4 + (b) * 2 + (h)) * HTB)
#define PG8_STAGE(bufoff, gbase, voff) do { _Pragma("unroll") for (int _i = 0; _i < 2; ++_i) \
        __builtin_amdgcn_global_load_lds((const unsigned*)((const char*)(gbase) + (voff)[_i]), (PG8_LAS unsigned*)(lds + (bufoff) + ldsw + _i * 8192), 16, 0, 0); } while (0)
#define PG8_LDA(dst, b, h) do { _Pragma("unroll") for (int m = 0; m < 4; ++m) _Pragma("unroll") for (int k = 0; k < 2; ++k) dst[m][k] = *(const PG8_LAS bf16x8*)(lds + PG8_SA(b, h) + aoff + m * 2048 + k * 1024); } while (0)
#define PG8_LDB(dst, b, h) do { _Pragma("unroll") for (int n = 0; n < 2; ++n) _Pragma("unroll") for (int k = 0; k < 2; ++k) dst[n][k] = *(const PG8_LAS bf16x8*)(lds + PG8_SB(b, h) + boff + n * 2048 + k * 1024); } while (0)
#define PG8_MMA(ai, bj, At, Bt) do { __builtin_amdgcn_s_setprio(1); _Pragma("unroll") for (int m = 0; m < 4; ++m) _Pragma("unroll") for (int n = 0; n < 2; ++n) _Pragma("unroll") for (int k = 0; k < 2; ++k) \
        acc[ai][bj][m][n] = mma16<Epi::F16>(Bt[n][k], At[m][k], acc[ai][bj][m][n]); __builtin_amdgcn_s_setprio(0); } while (0)
#define PG8_WAIT_V(n) asm volatile("s_waitcnt vmcnt(" #n ")" ::: "memory")
#define PG8_WAIT_L(n) asm volatile("s_waitcnt lgkmcnt(" #n ")" ::: "memory")
#define PG8_BAR __builtin_amdgcn_s_barrier()
#define PG8_SCHED __builtin_amdgcn_sched_barrier(0)
    Unit cur, nxt; int ui = 0;
    if (!S.next(0, cur)) return;
    f32x4 acc[2][2][4][2];
#pragma unroll
    for (int a = 0; a < 2; ++a)
#pragma unroll
        for (int b = 0; b < 2; ++b)
#pragma unroll
            for (int m = 0; m < 4; ++m)
#pragma unroll
                for (int n = 0; n < 2; ++n) acc[a][b][m][n] = (f32x4){0.f, 0.f, 0.f, 0.f};
    bf16x8 At[4][2], B0[2][2], B1[2][2];
    const char* cA = (const char*)g.A + (size_t)cur.pm * tstep; const char* cB = (const char*)g.Bt + (size_t)cur.pn * tstep;
    const char* cA2 = (const char*)g.A2 + (size_t)cur.pm * tstep + (size_t)cur.pn * (BM * 2); const char* const cB2 = (const char*)g.B2;
#define PG8_TA(t_) ((t_) < ntm ? cA + (size_t)(t_) * kstep : cA2 + (size_t)((t_) - ntm) * kstep)
#define PG8_TB(t_) ((t_) < ntm ? cB + (size_t)(t_) * kstep : cB2 + (size_t)((t_) - ntm) * kstep)
    S.a_ready(cur);
    typename Epi::Pre pre; E.prefetch(pre, cur, wr, wc, lane);
    PG8_STAGE(PG8_SB(0, 0), cB, voffB); PG8_STAGE(PG8_SB(0, 1), cB + hstep, voffB); PG8_STAGE(PG8_SA(0, 0), cA, voffA); PG8_STAGE(PG8_SA(0, 1), cA + hstep, voffA);
    if (wr == 1) PG8_BAR;
    PG8_WAIT_V(2); PG8_BAR;
    PG8_STAGE(PG8_SB(1, 0), cB + kstep, voffB); PG8_STAGE(PG8_SA(1, 0), cA + kstep, voffA); PG8_STAGE(PG8_SB(1, 1), cB + hstep + kstep, voffB);
    PG8_WAIT_V(6); PG8_BAR;
    PG8_STAMP();
    for (;;) {
        const bool has_next = S.next(ui + 1, nxt);
        const char* nA = has_next ? (const char*)g.A + (size_t)nxt.pm * tstep : cA; const char* nB = has_next ? (const char*)g.Bt + (size_t)nxt.pn * tstep : cB;
        for (int t = 0; t < nt; t += 2) {
            const bool last = (t == nt - 2);
            const char* a1 = PG8_TA(t + 1);
            const char* a2 = last ? nA : PG8_TA(t + 2); const char* b2 = last ? nB : PG8_TB(t + 2);
            const char* a3 = a2 + kstep; const char* b3 = b2 + kstep;
            if (last && has_next) S.a_ready(nxt);
            PG8_LDB(B0, 0, 0); PG8_LDB(B1, 0, 1); PG8_SCHED; PG8_LDA(At, 0, 0); PG8_STAGE(PG8_SA(1, 1), a1 + hstep, voffA);
            PG8_WAIT_V(8); PG8_WAIT_L(0); PG8_BAR; PG8_MMA(0, 0, At, B0); PG8_MMA(0, 1, At, B1); PG8_BAR; PG8_SCHED;
            PG8_LDA(At, 0, 1); PG8_STAGE(PG8_SB(0, 0), b2, voffB); PG8_STAGE(PG8_SB(0, 1), b2 + hstep, voffB); PG8_STAGE(PG8_SA(0, 0), a2, voffA);
            PG8_WAIT_V(8); PG8_WAIT_L(0); PG8_BAR; PG8_MMA(1, 0, At, B0); PG8_MMA(1, 1, At, B1); PG8_BAR; PG8_SCHED;
            PG8_LDB(B0, 1, 0); PG8_LDB(B1, 1, 1); PG8_SCHED; PG8_LDA(At, 1, 0); PG8_STAGE(PG8_SA(0, 1), a2 + hstep, voffA);
            PG8_WAIT_V(8); PG8_WAIT_L(0); PG8_BAR; PG8_MMA(0, 0, At, B0); PG8_MMA(0, 1, At, B1); PG8_BAR; PG8_SCHED;
            PG8_LDA(At, 1, 1); PG8_STAGE(PG8_SB(1, 0), b3, voffB); PG8_STAGE(PG8_SB(1, 1), b3 + hstep, voffB); PG8_STAGE(PG8_SA(1, 0), a3, voffA);
            PG8_WAIT_V(8); PG8_WAIT_L(0); PG8_BAR; PG8_MMA(1, 0, At, B0); PG8_MMA(1, 1, At, B1); PG8_BAR; PG8_SCHED;
        }
        PG8_STAMP();
        if (wr == 0) PG8_BAR;
        if constexpr (!Epi::AFTER_DRAIN) { E(acc, cur, wr, wc, fr, fq, pre); if (has_next) E.prefetch(pre, nxt, wr, wc, lane); S.done(cur); }
        PG8_STAMP();
        if (!has_next) break;
#pragma unroll
        for (int a = 0; a < 2; ++a)
#pragma unroll
            for (int b = 0; b < 2; ++b)
#pragma unroll
                for (int m = 0; m < 4; ++m)
#pragma unroll
                    for (int n = 0; n < 2; ++n) acc[a][b][m][n] = (f32x4){0.f, 0.f, 0.f, 0.f};
        cur = nxt; cA = nA; cB = nB; cA2 = (const char*)g.A2 + (size_t)cur.pm * tstep + (size_t)cur.pn * (BM * 2); ++ui;
        if (wr == 1) PG8_BAR;
    }
    PG8_WAIT_V(0);
    PG8_BAR;
    if constexpr (Epi::AFTER_DRAIN) { E.fused(acc, cur, wr, wc, fr, fq, lds, wid, lane); S.done(cur); }
    PG8_STAMP();
    if (STAMP && wid == 0) { stamps[lane] = lane < nts ? (((unsigned long long)(unsigned)ts_hi << 32) | (unsigned)ts_lo) : 0ull;
        if (lane == 62) stamps[62] = rt_entry; if (lane == 63) stamps[63] = (unsigned long long)wall_clock64(); }
#undef PG8_STAMP
#undef PG8_TA
#undef PG8_TB
#undef PG8_SA
#undef PG8_SB
#undef PG8_STAGE
#undef PG8_LDA
#undef PG8_LDB
#undef PG8_MMA
#undef PG8_WAIT_V
#undef PG8_WAIT_L
#undef PG8_BAR
#undef PG8_SCHED
}
}

#ifdef PROBE_BAR3
#define PROBE_EXTRA_BAR xcd_barrier(xb); xcd_barrier(xb);
#else
#define PROBE_EXTRA_BAR
#endif
#ifndef PROBE_NTE
#define PROBE_NTE 4
#endif
#ifndef STREAM_F16
#define STREAM_F16 0
#endif
#ifndef MK_COOP
#define MK_COOP 1
#endif
#define LAS __attribute__((address_space(3)))
typedef unsigned short bf16_t;
typedef short bf16x8 __attribute__((ext_vector_type(8)));
typedef short s16x4 __attribute__((ext_vector_type(4)));
typedef float f32x4 __attribute__((ext_vector_type(4)));
typedef float f32x2 __attribute__((ext_vector_type(2)));
typedef unsigned u32x4 __attribute__((ext_vector_type(4)));
typedef unsigned u32x2 __attribute__((ext_vector_type(2)));

constexpr int MTOK = 32768, DM = 2048, DIN = 6400, NLAYER = 4;
constexpr int ROWS_PROMPT = 16384;
constexpr float LN_EPS = 1e-5f;
constexpr float ALPHA = 1.681792830507429f;
constexpr float LOG2E = 1.4426950408889634f;
constexpr int C_AU = 0, C_AV = 512, C_AG = 1024, C_BA = 1536, C_BB = 2048, C_BG = 2560, C_Q = 3072, C_K = 3584, C_V = 3712, C_CG = 3840,
              C_DB = 4352, C_DC = 4864, C_DX = 5376, C_DG = 5888;
constexpr size_t WS_WIN = 0;
constexpr size_t WS_WOUT = WS_WIN + (size_t)NLAYER * DIN * DM * 2;
constexpr size_t WS_XB = WS_WOUT + (size_t)NLAYER * DM * DM * 2;
constexpr size_t WS_Y = WS_XB + (size_t)MTOK * DM * 2;
constexpr size_t WS_H = WS_Y + (size_t)MTOK * DM * 2;
constexpr size_t WS_SGUW = WS_H + (size_t)MTOK * DIN * 2;
constexpr size_t WS_BI = WS_SGUW + (size_t)NLAYER * 4 * 128 * 128 * 2;
constexpr size_t WS_CTL = WS_BI + (size_t)256 * DM * 2;
constexpr size_t WS_BAR = WS_CTL;
constexpr size_t WS_CS = WS_BAR + 16384;
constexpr size_t WS_BW = WS_CS + (size_t)NLAYER * DIN * 4;
constexpr size_t WS_STATS = WS_BW + (size_t)NLAYER * DIN * 4;
constexpr size_t WS_END2 = WS_STATS + (size_t)NLAYER * MTOK * 2 * 4;
constexpr size_t CTL_BYTES = WS_END2 - WS_CTL;
constexpr int LDS_BYTES = 136 * 1024;
constexpr int LDS_BARST = LDS_BYTES - 16;
constexpr int NPHASE = 2 + 3 * NLAYER;
constexpr int LDS_YSC = 133120;

struct P {
    const float *x_prompt, *x_sample, *w_in, *w_out, *sgu_ln_g, *sgu_ln_b, *sgu_w, *sgu_b, *cm_conv_w, *cm_conv_b, *cm_ln_g, *cm_ln_b, *attn_sink, *sc_conv_w, *post_ln_g, *post_ln_b;
    float* out; unsigned char* ws; int ph_lo, ph_hi;
};

__device__ __forceinline__ float bflo(unsigned w) { return __uint_as_float(w << 16); }
__device__ __forceinline__ float bfhi(unsigned w) { return __uint_as_float(w & 0xffff0000u); }
__device__ __forceinline__ float bf1(bf16_t b) { return __uint_as_float(((unsigned)b) << 16); }
__device__ __forceinline__ unsigned pk2(float lo, float hi) { return pg8::cvt_pk_bf16(lo, hi); }
typedef _Float16 f16x2e __attribute__((ext_vector_type(2)));
typedef _Float16 f16x4e __attribute__((ext_vector_type(4)));
__device__ __forceinline__ unsigned pkh2e(float lo, float hi) { const f16x2e v = {(_Float16)lo, (_Float16)hi}; return __builtin_bit_cast(unsigned, v); }
__device__ __forceinline__ void unpack8(const u32x4 r, float (&v)[8]) {
    v[0] = bflo(r.x); v[1] = bfhi(r.x); v[2] = bflo(r.y); v[3] = bfhi(r.y); v[4] = bflo(r.z); v[5] = bfhi(r.z); v[6] = bflo(r.w); v[7] = bfhi(r.w); }
__device__ __forceinline__ u32x4 pack8(const float (&v)[8]) { u32x4 w; w.x = pk2(v[0], v[1]); w.y = pk2(v[2], v[3]); w.z = pk2(v[4], v[5]); w.w = pk2(v[6], v[7]); return w; }
__device__ __forceinline__ float ex2(float x) { return __builtin_amdgcn_exp2f(x); }
__device__ __forceinline__ float sigm_f(float x) { return __builtin_amdgcn_rcpf(1.0f + ex2(-x * LOG2E)); }
__device__ __forceinline__ float silu_f(float x) { return x * sigm_f(x); }
__device__ __forceinline__ float wave_sum(float v) { v += __shfl_xor(v, 32); v += __shfl_xor(v, 16); v += __shfl_xor(v, 8); v += __shfl_xor(v, 4); v += __shfl_xor(v, 2); v += __shfl_xor(v, 1); return v; }
__device__ __forceinline__ void seq_of_row(int row0, int& pos0, int& S) { if (row0 < ROWS_PROMPT) { S = 2048; pos0 = row0 & 2047; } else { S = 4096; pos0 = (row0 - ROWS_PROMPT) & 4095; } }

#define XB_TMO      128
#define XB_XCNT(j)  (256  + 64 * (j))
#define XB_XSUB(j)  (1280 + 64 * (j))
#define XB_XGEN(j)  (2304 + 64 * (j))
#define XB_TOP      3328
#define XB_TOPGEN   3392
#define XCD_BAR_WORDS 3456
#define XB_SPIN_CAP (1u << 18)

__device__ __forceinline__ unsigned xb_ld(unsigned* p)              { return __hip_atomic_load(p, __ATOMIC_RELAXED, __HIP_MEMORY_SCOPE_AGENT); }
__device__ __forceinline__ unsigned xb_add(unsigned* p, unsigned v) { return __hip_atomic_fetch_add(p, v, __ATOMIC_RELAXED, __HIP_MEMORY_SCOPE_AGENT); }
__device__ __forceinline__ unsigned xb_xcc_id() { return (unsigned)__builtin_amdgcn_s_getreg((3 << 11) | 20) & 0xFu; }
#define XB_SPIN(cond, bar) do { unsigned _sp = 0; while (cond) { __builtin_amdgcn_s_sleep(1); \
    if ((++_sp & 255u) == 0u) { if (xb_ld(&(bar)[XB_TMO])) break; if (_sp > XB_SPIN_CAP) { atomicAdd(&(bar)[XB_TMO], 1u); break; } } } } while (0)

struct XcdBarrier {
    unsigned* bar; unsigned x;
    volatile LAS unsigned* st;
};

__device__ __forceinline__ XcdBarrier xcd_barrier_post(unsigned* bar, volatile LAS unsigned* st) {
    XcdBarrier b; b.bar = bar; b.x = xb_xcc_id(); b.st = st;
    if (threadIdx.x == 0) (void)xb_add(&bar[XB_XCNT(b.x)], 1u);
    return b;
}
__device__ __forceinline__ void xcd_barrier_complete(unsigned* bar, unsigned x, unsigned& nloc, unsigned& nx) {
    const unsigned G = gridDim.x * gridDim.y * gridDim.z;
    unsigned sum, cnt, mine, sp = 0u;
    for (;;) {
        sum = 0u; cnt = 0u; mine = 0u;
#pragma unroll
        for (unsigned j = 0; j < 16; ++j) { const unsigned c = xb_ld(&bar[XB_XCNT(j)]); sum += c; cnt += (c > 0u) ? 1u : 0u; mine = (j == x) ? c : mine; }
        if (sum == G) break;
        __builtin_amdgcn_s_sleep(1);
        if ((++sp & 255u) == 0u) { if (xb_ld(&bar[XB_TMO])) break; if (sp > XB_SPIN_CAP) { atomicAdd(&bar[XB_TMO], 1u); break; } }
    }
    nloc = mine > 0u ? mine : 1u; nx = cnt > 0u ? cnt : 1u;
}

__device__ __forceinline__ void xcd_barrier(const XcdBarrier& b) {
    asm volatile("s_waitcnt vmcnt(0)" ::: "memory");
    __syncthreads();
    if (threadIdx.x == 0) {
        unsigned* bar = b.bar;
        __builtin_amdgcn_s_waitcnt(0);
        unsigned nloc = b.st[0], nx = b.st[1];
        if (nloc == 0u) { xcd_barrier_complete(bar, b.x, nloc, nx); b.st[0] = nloc; b.st[1] = nx; }
        const unsigned old = xb_add(&bar[XB_XSUB(b.x)], 1u);
        const unsigned gen = old / nloc;
        if (old + 1u == (gen + 1u) * nloc) {
            __builtin_amdgcn_fence(__ATOMIC_RELEASE, "agent");
            asm volatile("s_waitcnt vmcnt(0)" ::: "memory");
            const unsigned og = xb_add(&bar[XB_TOP], 1u);
            const unsigned tg = og / nx;
            if (og + 1u == (tg + 1u) * nx) xb_add(&bar[XB_TOPGEN], 1u);
            else XB_SPIN(xb_ld(&bar[XB_TOPGEN]) == tg, bar);
            __builtin_amdgcn_fence(__ATOMIC_ACQUIRE, "agent");
            xb_add(&bar[XB_XGEN(b.x)], 1u);
            asm volatile("s_waitcnt vmcnt(0)" ::: "memory");
        } else {
            XB_SPIN(xb_ld(&bar[XB_XGEN(b.x)]) == gen, bar);
            __builtin_amdgcn_fence(__ATOMIC_ACQUIRE, "agent");
            asm volatile("s_waitcnt vmcnt(0)" ::: "memory");
        }
    }
    __syncthreads();
}


struct OrderSh : pg8::StaticOrder { int sh; __device__ bool next(int i, pg8::Unit& u) const { return pg8::StaticOrder::next(i >> sh, u); } };
struct Order2 : pg8::StaticOrder { __device__ bool next(int i, pg8::Unit& u) const { return pg8::StaticOrder::next(i >> 1, u); } };
typedef const __attribute__((address_space(4))) P* KArgPtr;
__device__ __forceinline__ P load_params(KArgPtr kp) {
#if defined(__HIP_DEVICE_COMPILE__)
    asm volatile("" : "+s"(kp)); P r;
    r.x_prompt = kp->x_prompt; r.x_sample = kp->x_sample; r.w_in = kp->w_in; r.w_out = kp->w_out; r.sgu_ln_g = kp->sgu_ln_g; r.sgu_ln_b = kp->sgu_ln_b; r.sgu_w = kp->sgu_w; r.sgu_b = kp->sgu_b;
    r.cm_conv_w = kp->cm_conv_w; r.cm_conv_b = kp->cm_conv_b; r.cm_ln_g = kp->cm_ln_g; r.cm_ln_b = kp->cm_ln_b; r.attn_sink = kp->attn_sink; r.sc_conv_w = kp->sc_conv_w; r.post_ln_g = kp->post_ln_g; r.post_ln_b = kp->post_ln_b;
    r.out = kp->out; r.ws = kp->ws; r.ph_lo = kp->ph_lo; r.ph_hi = kp->ph_hi; return r;
#else
    return P{};
#endif
}
constexpr float FX_S1 = 16384.0f, FX_S2 = 4096.0f, FX_CS = 16777216.0f;
__device__ __forceinline__ void stats_decode(const f32x2 v, float& mean, float& rstd) {
    const int lo = __float_as_int(v.x); const unsigned hi = __float_as_uint(v.y) + (lo < 0 ? 1u : 0u);
    const float s1 = (float)lo * (1.0f / FX_S1), s2 = (float)hi * (1.0f / FX_S2);
    mean = s1 * (1.0f / DM); const float var = s2 * (1.0f / DM) - mean * mean; rstd = rsqrtf(var + LN_EPS); }
__device__ __forceinline__ void row_mean_rstd(const float* st, int row, float& mean, float& rstd) { stats_decode(*(const f32x2*)(st + 2 * (size_t)row), mean, rstd); }
__device__ __forceinline__ void mean_rstd_of(const f32x2 v, bool plain, float& mean, float& rstd) { float m, r; stats_decode(v, m, r); mean = plain ? 0.f : m; rstd = plain ? 1.f : r; }

struct EpiPre { f32x2 st[2]; f32x2 cv; };
struct EpiH {
    static constexpr bool PERM = true, AFTER_DRAIN = false, F16 = (STREAM_F16 != 0);
    typedef EpiPre Pre;
    KArgPtr kp; int l;
    __device__ __forceinline__ void prefetch(Pre& pre, const pg8::Unit& u, int wr, int wc, int lane) const {
        KArgPtr kq = kp; asm volatile("" : "+s"(kq)); unsigned char* const ws = kq->ws;
        const float* cs = (const float*)(ws + WS_CS) + l * DIN; const float* bw = (const float*)(ws + WS_BW) + l * DIN;
        const float* st = (const float*)(ws + WS_STATS) + (size_t)(l > 0 ? l - 1 : 0) * MTOK * 2;
        const int r = u.pm * 256 + wr * 64 + lane, c = u.pn * 256 + (lane >> 5) * 128 + wc * 32 + (lane & 31);
        pre.st[0] = *(const f32x2*)(st + 2 * (size_t)r); pre.st[1] = *(const f32x2*)(st + 2 * (size_t)(r + 128));
        pre.cv = (f32x2){(float)__float_as_int(cs[c]) * (1.0f / FX_CS), (float)__float_as_int(bw[c]) * (1.0f / FX_CS)};
    }
    __device__ __forceinline__ void operator()(const f32x4 (&acc)[2][2][4][2], const pg8::Unit& u, int wr, int wc, int fr, int fq, const Pre& pre) const {
        KArgPtr kq = kp; asm volatile("" : "+s"(kq)); unsigned char* const ws = kq->ws; const bool plain = (l == 0);
        bf16_t* O = (bf16_t*)(ws + WS_H);
        const int pn = u.pn; const int act = (pn == 4 || pn == 5 || pn == 10 || pn == 11 || pn == 15 || pn == 16 || pn == 23 || pn == 24) ? 1 : ((pn == 8 || pn == 9) ? 2 : 0);
        const int row0 = u.pm * 256 + wr * 64 + fr, col0 = u.pn * 256 + wc * 32 + 8 * fq;
        f32x4 c[2][2], w[2][2];
#pragma unroll
        for (int bj = 0; bj < 2; ++bj)
#pragma unroll
            for (int n = 0; n < 2; ++n)
#pragma unroll
                for (int j = 0; j < 4; ++j) { const int src = bj * 32 + 8 * fq + 4 * n + j; c[bj][n][j] = __shfl(pre.cv.x, src); w[bj][n][j] = __shfl(pre.cv.y, src); }
#pragma unroll
        for (int ai = 0; ai < 2; ++ai)
#pragma unroll
            for (int m = 0; m < 4; ++m) { const int row = row0 + ai * 128 + m * 16; const f32x2 sv = (f32x2){__shfl(pre.st[ai].x, m * 16 + fr), __shfl(pre.st[ai].y, m * 16 + fr)};
                float mean, rstd; mean_rstd_of(sv, plain, mean, rstd);
                const float mr = -mean * rstd; bf16_t* rowp = O + (size_t)row * DIN + col0;
#pragma unroll
                for (int bj = 0; bj < 2; ++bj) { f32x4 v0 = acc[ai][bj][m][0] * rstd + (c[bj][0] * mr + w[bj][0]), v1 = acc[ai][bj][m][1] * rstd + (c[bj][1] * mr + w[bj][1]);
                    if (act) {
#pragma unroll
                        for (int j = 0; j < 4; ++j) { const float s0 = sigm_f(v0[j]), s1 = sigm_f(v1[j]); v0[j] = (act == 1) ? v0[j] * s0 : s0; v1[j] = (act == 1) ? v1[j] * s1 : s1; } }
                    u32x4 o; o.x = pk2(v0[0], v0[1]); o.y = pk2(v0[2], v0[3]); o.z = pk2(v1[0], v1[1]); o.w = pk2(v1[2], v1[3]); *(u32x4*)(rowp + bj * 128) = o; } }
    }
};

typedef _Float16 f16x2 __attribute__((ext_vector_type(2)));
#if STREAM_F16
__device__ __forceinline__ unsigned pkh2(float lo, float hi) { return __builtin_bit_cast(unsigned, __builtin_amdgcn_cvt_pkrtz(lo, hi)); }
__device__ __forceinline__ f32x4 unpackh4(const u32x2 w) { const f16x2 a = __builtin_bit_cast(f16x2, w.x), b = __builtin_bit_cast(f16x2, w.y); return (f32x4){(float)a.x, (float)a.y, (float)b.x, (float)b.y}; }
#else
__device__ __forceinline__ unsigned pkh2(float lo, float hi) { return pk2(lo, hi); }
__device__ __forceinline__ f32x4 unpackh4(const u32x2 w) { return (f32x4){bflo(w.x), bfhi(w.x), bflo(w.y), bfhi(w.y)}; }
#endif

struct EpiZ {
    static constexpr bool PERM = true, AFTER_DRAIN = false, F16 = false;
    typedef EpiPre Pre;
    KArgPtr kp; int l;
    __device__ __forceinline__ void prefetch(Pre& pre, const pg8::Unit& u, int wr, int wc, int lane) const {
        KArgPtr kq = kp; asm volatile("" : "+s"(kq)); unsigned char* const ws = kq->ws; const int lp = l > 0 ? l - 1 : 0;
        const float* stp = (const float*)(ws + WS_STATS) + (size_t)lp * MTOK * 2; const float* g = kq->post_ln_g + lp * DM; const float* b = kq->post_ln_b + lp * DM;
        const int r = u.pm * 256 + wr * 64 + lane, c = u.pn * 256 + (lane >> 5) * 128 + wc * 32 + (lane & 31);
        pre.st[0] = *(const f32x2*)(stp + 2 * (size_t)r); pre.st[1] = *(const f32x2*)(stp + 2 * (size_t)(r + 128));
        pre.cv = (f32x2){g[c], b[c]};
    }
    __device__ __forceinline__ void operator()(const f32x4 (&acc)[2][2][4][2], const pg8::Unit& u, int wr, int wc, int fr, int fq, const Pre& pre) const {
        KArgPtr kq = kp; asm volatile("" : "+s"(kq)); const bool layer0 = (l == 0), lastl = (l == NLAYER - 1); const int lp = l > 0 ? l - 1 : 0;
        unsigned char* const ws = kq->ws; float* out = kq->out; bf16_t* XB = (bf16_t*)(ws + WS_XB);
        const float* stp = (const float*)(ws + WS_STATS) + (size_t)lp * MTOK * 2; float* stn = (float*)(ws + WS_STATS) + (size_t)l * MTOK * 2;
        const float* g = kq->post_ln_g + lp * DM; const float* b = kq->post_ln_b + lp * DM;
        const int row0 = u.pm * 256 + wr * 64 + fr, col0 = u.pn * 256 + wc * 32 + 8 * fq;
        f32x4 gv[2][2], bv[2][2]; f32x2 sv[8];
#pragma unroll
        for (int rg = 0; rg < 8; ++rg) sv[rg] = (f32x2){__shfl(pre.st[rg >> 2].x, (rg & 3) * 16 + fr), __shfl(pre.st[rg >> 2].y, (rg & 3) * 16 + fr)};
#pragma unroll
        for (int bj = 0; bj < 2; ++bj)
#pragma unroll
            for (int n = 0; n < 2; ++n) { f32x4 g4, b4;
#pragma unroll
                for (int j = 0; j < 4; ++j) { const int src = bj * 32 + 8 * fq + 4 * n + j; g4[j] = __shfl(pre.cv.x, src); b4[j] = __shfl(pre.cv.y, src); }
                gv[bj][n] = layer0 ? (f32x4){ALPHA, ALPHA, ALPHA, ALPHA} : g4 * ALPHA; bv[bj][n] = layer0 ? (f32x4){0.f, 0.f, 0.f, 0.f} : b4 * ALPHA; }
#pragma unroll
        for (int rg = 0; rg < 8; ++rg) {
            const int ai = rg >> 2, m = rg & 3;
            const int row = row0 + ai * 128 + m * 16; const size_t off = (size_t)row * DM + col0;
            float mean, rstd; mean_rstd_of(sv[rg], layer0, mean, rstd);
            bf16_t* dstb = XB + off; float* dst = out + off;
            float s1 = 0.f, s2 = 0.f;
#pragma unroll
            for (int bj = 0; bj < 2; ++bj) {
                const f32x4 z0 = (acc[ai][bj][m][0] - mean) * rstd * gv[bj][0] + bv[bj][0], z1 = (acc[ai][bj][m][1] - mean) * rstd * gv[bj][1] + bv[bj][1];
                u32x4 w; if (lastl) { w.x = pkh2e(z0[0], z0[1]); w.y = pkh2e(z0[2], z0[3]); w.z = pkh2e(z1[0], z1[1]); w.w = pkh2e(z1[2], z1[3]); }
                else { w.x = pk2(z0[0], z0[1]); w.y = pk2(z0[2], z0[3]); w.z = pk2(z1[0], z1[1]); w.w = pk2(z1[2], z1[3]); }
                *(u32x4*)(dstb + bj * 128) = w;
                s1 += ((z0[0] + z0[1]) + (z0[2] + z0[3])) + ((z1[0] + z1[1]) + (z1[2] + z1[3]));
                s2 += ((z0[0] * z0[0] + z0[1] * z0[1]) + (z0[2] * z0[2] + z0[3] * z0[3])) + ((z1[0] * z1[0] + z1[1] * z1[1]) + (z1[2] * z1[2] + z1[3] * z1[3])); }
            s1 += __shfl_xor(s1, 16); s1 += __shfl_xor(s1, 32); s2 += __shfl_xor(s2, 16); s2 += __shfl_xor(s2, 32);
            if (fq == 0) { const long long packed = (long long)(((unsigned long long)(unsigned)__float2int_rn(s2 * FX_S2)) << 32) + (long long)__float2int_rn(s1 * FX_S1);
                atomicAdd((unsigned long long*)stn + (size_t)row, (unsigned long long)packed); }
        }
    }
};

constexpr int NT_LAYER = 1600 + 512;
__device__ __forceinline__ void prep_tile_src(const P& p, int l, int tq, const float*& src, bf16_t*& dst, int& N, int& fold  , int& kbase, int& nbase, bool& is_win) {
    bf16_t* WinT = (bf16_t*)(p.ws + WS_WIN); bf16_t* WoutT = (bf16_t*)(p.ws + WS_WOUT);
    int kt, ntl; fold = l - 1;
    if (tq < 1600) { kt = tq / 100; ntl = tq % 100; N = DIN; src = p.w_in + (size_t)l * DM * DIN; dst = WinT + (size_t)l * DIN * DM; nbase = l * DIN + ntl * 64; is_win = true; }
    else { const int r = tq - 1600; kt = r / 32; ntl = r % 32; N = DM; src = p.w_out + (size_t)l * DM * DM; dst = WoutT + (size_t)l * DM * DM; nbase = ntl * 64; is_win = false; }
    kbase = kt * 128;
    src += (size_t)(kt * 128) * N + ntl * 64; dst += (size_t)(ntl * 64) * DM + kt * 128;
}
__device__ __forceinline__ void prep_weights(const P& p, LAS unsigned char* lds, int l0, int l1, int tq_lo, int tq_hi, int first, int stride) {
    int tid = threadIdx.x; asm volatile("" : "+v"(tid));
    LAS float* tile = (LAS float*)lds;
    LAS float* gsm = tile + 128 * 65;
    float* CS = (float*)(p.ws + WS_CS); float* BW = (float*)(p.ws + WS_BW);
    const int NTL = tq_hi - tq_lo; const int NT = (l1 - l0) * NTL;
    const int lr = tid >> 4, c4 = tid & 15;
    f32x4 pre[4];
    { int t = first; if (t < NT) { const float* src; bf16_t* dst; int N, fold, kb, nb; bool iw; prep_tile_src(p, l0 + t / NTL, tq_lo + t % NTL, src, dst, N, fold, kb, nb, iw);
#pragma unroll
        for (int ps = 0; ps < 4; ++ps) pre[ps] = *(const f32x4*)(src + (size_t)(lr + 32 * ps) * N + 4 * c4); } }
    for (int t = first; t < NT; t += stride) {
        const float* src; bf16_t* dst; int N, fold, kb, nb; bool is_win; prep_tile_src(p, l0 + t / NTL, tq_lo + t % NTL, src, dst, N, fold, kb, nb, is_win);
#pragma unroll
        for (int ps = 0; ps < 4; ++ps) { const int row = lr + 32 * ps;
            tile[row * 65 + 4 * c4 + 0] = pre[ps][0]; tile[row * 65 + 4 * c4 + 1] = pre[ps][1]; tile[row * 65 + 4 * c4 + 2] = pre[ps][2]; tile[row * 65 + 4 * c4 + 3] = pre[ps][3]; }
        if (tid < 256) { const int k = tid & 127; float v = (tid < 128) ? 1.0f : 0.0f;
            if (is_win && fold >= 0) v = (tid < 128) ? p.post_ln_g[fold * DM + kb + k] : p.post_ln_b[fold * DM + kb + k];
            gsm[tid] = v; }
        if (t + stride < NT) { const float* src2; bf16_t* dst2; int N2, f2, kb2, nb2; bool iw2; prep_tile_src(p, l0 + (t + stride) / NTL, tq_lo + (t + stride) % NTL, src2, dst2, N2, f2, kb2, nb2, iw2);
#pragma unroll
            for (int ps = 0; ps < 4; ++ps) pre[ps] = *(const f32x4*)(src2 + (size_t)(lr + 32 * ps) * N2 + 4 * c4); }
        __syncthreads();
#pragma unroll
        for (int ps = 0; ps < 2; ++ps) { const int idx = tid + 512 * ps; const int n = idx >> 4, k8 = idx & 15; float f[8]; float csp = 0.f, bwp = 0.f;
            const float cscale = (!is_win && fold >= 0) ? 1.0f / p.post_ln_g[fold * DM + nb + n] : 1.0f;
#pragma unroll
            for (int j = 0; j < 8; ++j) { const float w = tile[(8 * k8 + j) * 65 + n]; f[j] = w * gsm[8 * k8 + j] * cscale; csp += f[j]; bwp += w * gsm[128 + 8 * k8 + j]; }
            *(u32x4*)(dst + (size_t)n * DM + 8 * k8) = pack8(f);
            if (is_win && fold >= 0) {
                csp += __shfl_xor(csp, 1); csp += __shfl_xor(csp, 2); csp += __shfl_xor(csp, 4); csp += __shfl_xor(csp, 8);
                bwp += __shfl_xor(bwp, 1); bwp += __shfl_xor(bwp, 2); bwp += __shfl_xor(bwp, 4); bwp += __shfl_xor(bwp, 8);
                if (k8 == 0) { atomicAdd((int*)CS + nb + n, __float2int_rn(csp * FX_CS)); atomicAdd((int*)BW + nb + n, __float2int_rn(bwp * FX_CS)); } } }
        __syncthreads();
    }
}
__device__ __forceinline__ bool defer_prep() { return gridDim.x == 256; }
__device__ __forceinline__ void phase_prep(const P& p, LAS unsigned char* lds) {
    int tid = threadIdx.x; asm volatile("" : "+v"(tid)); const int G = gridDim.x, b = blockIdx.x;
    prep_weights(p, lds, 0, 1, 0, NT_LAYER, b, G);
    if (defer_prep()) prep_weights(p, lds, 1, NLAYER, 1600, NT_LAYER, b, G);
    else prep_weights(p, lds, 1, NLAYER, 0, NT_LAYER, b, G);
    {
        bf16_t* BI = (bf16_t*)(p.ws + WS_BI);
        for (int c = b * 512 + tid; c < 256 * DM / 8; c += G * 512) { const int r = c >> 8, c8 = (c & 255) * 8; u32x4 w = (u32x4){0u, 0u, 0u, 0u};
            if (r >= c8 && r < c8 + 8) { const int j = r - c8; const unsigned one = 0x3F80u << ((j & 1) * 16); if ((j >> 1) == 0) w.x = one; else if ((j >> 1) == 1) w.y = one; else if ((j >> 1) == 2) w.z = one; else w.w = one; }
            *(u32x4*)(BI + (size_t)c * 8) = w; }
    }
    bf16_t* XB = (bf16_t*)(p.ws + WS_XB);
    constexpr size_t NCH = (size_t)MTOK * DM / 8, HALFCH = (size_t)ROWS_PROMPT * DM / 8;
    {
        f32x4 va[4], vb[4]; const size_t step = (size_t)G * 2048; size_t c = (size_t)b * 2048 + tid;
#define XCONV_LOADS(c_) do { _Pragma("unroll") for (int u = 0; u < 4; ++u) { const size_t cc = (c_) + 512 * u; const float* sp = cc < HALFCH ? p.x_prompt + cc * 8 : p.x_sample + (cc - HALFCH) * 8; va[u] = *(const f32x4*)sp; vb[u] = *(const f32x4*)(sp + 4); } } while (0)
        if (c < NCH) XCONV_LOADS(c);
        for (; c < NCH; c += step) {
            u32x4 w[4];
#pragma unroll
            for (int u = 0; u < 4; ++u) { w[u].x = pkh2(va[u][0], va[u][1]); w[u].y = pkh2(va[u][2], va[u][3]); w[u].z = pkh2(vb[u][0], vb[u][1]); w[u].w = pkh2(vb[u][2], vb[u][3]); }
            if (c + step < NCH) XCONV_LOADS(c + step);
#pragma unroll
            for (int u = 0; u < 4; ++u) *(u32x4*)(XB + (c + 512 * u) * 8) = w[u];
        }
#undef XCONV_LOADS
    }
    bf16_t* SW = (bf16_t*)(p.ws + WS_SGUW);
    for (int c = b * 512 + tid; c < NLAYER * 4 * 128 * 128 / 8; c += G * 512) {
        const float* sp = p.sgu_w + (size_t)c * 8; const f32x4 a = *(const f32x4*)sp, bq = *(const f32x4*)(sp + 4); u32x4 w; w.x = pkh2e(a[0], a[1]); w.y = pkh2e(a[2], a[3]); w.z = pkh2e(bq[0], bq[1]); w.w = pkh2e(bq[2], bq[3]);
        *(u32x4*)(SW + (size_t)c * 8) = w; }
}

constexpr int VN_PITCH = 520;
__device__ __forceinline__ void mixer_sgu(const P& p, int l, int row0, LAS unsigned char* lds) {
    int tid = threadIdx.x; asm volatile("" : "+v"(tid)); const int wave = tid >> 6, lane = tid & 63;
    const bf16_t* H = (const bf16_t*)(p.ws + WS_H); bf16_t* Y = (bf16_t*)(p.ws + WS_Y);
    LAS bf16_t* vn = (LAS bf16_t*)lds;
    bf16x8 wf[4][4];
    { const int hd = wave >> 1, th = wave & 1, r = lane & 15, q = lane >> 4;
      const bf16_t* W = (const bf16_t*)(p.ws + WS_SGUW) + (size_t)(l * 4 + hd) * 128 * 128;
#pragma unroll
      for (int ks = 0; ks < 4; ++ks)
#pragma unroll
          for (int tt = 0; tt < 4; ++tt) wf[ks][tt] = *(const bf16x8*)(W + (size_t)(64 * th + 16 * tt + r) * 128 + 32 * ks + 8 * q); }
    {
        float gg[8], bb[8];
        { const f32x4 g0 = *(const f32x4*)(p.sgu_ln_g + l * 512 + 8 * lane), g1 = *(const f32x4*)(p.sgu_ln_g + l * 512 + 8 * lane + 4);
          const f32x4 b0 = *(const f32x4*)(p.sgu_ln_b + l * 512 + 8 * lane), b1 = *(const f32x4*)(p.sgu_ln_b + l * 512 + 8 * lane + 4);
#pragma unroll
          for (int j = 0; j < 4; ++j) { gg[j] = g0[j]; gg[4 + j] = g1[j]; bb[j] = b0[j]; bb[4 + j] = b1[j]; } }
        u32x4 rawA[8], rawB[8];
#pragma unroll
        for (int i = 0; i < 8; ++i) rawA[i] = *(const u32x4*)(H + (size_t)(row0 + wave * 16 + i) * DIN + C_AV + 8 * lane);
#pragma unroll
        for (int i = 0; i < 8; ++i) rawB[i] = *(const u32x4*)(H + (size_t)(row0 + wave * 16 + 8 + i) * DIN + C_AV + 8 * lane);
#pragma unroll
        for (int i = 0; i < 16; ++i) { const int s = wave * 16 + i;
            float v[8]; if (i < 8) unpack8(rawA[i], v); else unpack8(rawB[i - 8], v);
            float sum = 0.f;
#pragma unroll
            for (int j = 0; j < 8; ++j) sum += v[j];
            const float mean = wave_sum(sum) * (1.0f / 512.0f);
            float q = 0.f;
#pragma unroll
            for (int j = 0; j < 8; ++j) { v[j] -= mean; q += v[j] * v[j]; }
            const float rstd = rsqrtf(wave_sum(q) * (1.0f / 512.0f) + LN_EPS);
#pragma unroll
            for (int j = 0; j < 8; ++j) v[j] = v[j] * rstd * gg[j] + bb[j];
            { u32x4 w; w.x = pkh2e(v[0], v[1]); w.y = pkh2e(v[2], v[3]); w.z = pkh2e(v[4], v[5]); w.w = pkh2e(v[6], v[7]); *(LAS u32x4*)(vn + s * VN_PITCH + 8 * lane) = w; } }
    }
    __syncthreads();
    {
        const int hd = wave >> 1, th = wave & 1, r = lane & 15, q = lane >> 4, qq = (lane >> 2) & 3, pp = lane & 3;
#pragma unroll 1
        for (int dh = 0; dh < 2; ++dh) {
        f32x4 acc[4][4];
#pragma unroll
        for (int a = 0; a < 4; ++a)
#pragma unroll
            for (int c = 0; c < 4; ++c) acc[a][c] = (f32x4){0.f, 0.f, 0.f, 0.f};
#pragma unroll
        for (int ks = 0; ks < 4; ++ks) {
#pragma unroll
            for (int dt = 0; dt < 4; ++dt) {
                const LAS bf16_t* ap = vn + (32 * ks + 8 * q + qq) * VN_PITCH + 128 * hd + 64 * dh + 32 * (dt >> 1) + 8 * pp + 4 * (dt & 1);
                const s16x4 lo = __builtin_amdgcn_ds_read_tr16_b64_v4i16((LAS s16x4*)ap);
                const s16x4 hi = __builtin_amdgcn_ds_read_tr16_b64_v4i16((LAS s16x4*)(ap + 4 * VN_PITCH));
                const bf16x8 af = {lo[0], lo[1], lo[2], lo[3], hi[0], hi[1], hi[2], hi[3]};
#pragma unroll
                for (int tt = 0; tt < 4; ++tt) acc[dt][tt] = pg8::mma16<true>(af, wf[ks][tt], acc[dt][tt]);
            }
        }
#pragma unroll
        for (int tt = 0; tt < 4; ++tt) { const int t = 64 * th + 16 * tt + r; const float bs = p.sgu_b[(l * 4 + hd) * 128 + t]; const float ysc = ((const LAS float*)(lds + LDS_YSC))[t];
            const bf16_t* hrow = H + (size_t)(row0 + t) * DIN; bf16_t* yrow = Y + (size_t)(row0 + t) * DM;
#pragma unroll
            for (int m = 0; m < 2; ++m) { const int d0 = 128 * hd + 64 * dh + 32 * m + 8 * q;
                const u32x4 uu = *(const u32x4*)(hrow + C_AU + d0), ag = *(const u32x4*)(hrow + C_AG + d0);
                float uv[8], gv[8], o[8]; unpack8(uu, uv); unpack8(ag, gv);
#pragma unroll
                for (int j = 0; j < 4; ++j) { o[j] = ysc * uv[j] * (acc[2 * m][tt][j] + bs) * gv[j]; o[4 + j] = ysc * uv[4 + j] * (acc[2 * m + 1][tt][j] + bs) * gv[4 + j]; }
                *(u32x4*)(yrow + d0) = pack8(o); } }
        }
    }
}

__device__ __forceinline__ void mixer_conf(const P& p, int l, int row0, int pos0, int S, LAS unsigned char* lds) {
    int tid = threadIdx.x; asm volatile("" : "+v"(tid)); const int wave = tid >> 6, lane = tid & 63;
    const bf16_t* H = (const bf16_t*)(p.ws + WS_H); bf16_t* Y = (bf16_t*)(p.ws + WS_Y);
    LAS float* gbuf = (LAS float*)lds;
    LAS float* cbuf = (LAS float*)(lds + 62 * 256 * 4);
    float lg[8], lb[8];
    { const f32x4 g0 = *(const f32x4*)(p.cm_ln_g + l * 512 + 8 * lane), g1 = *(const f32x4*)(p.cm_ln_g + l * 512 + 8 * lane + 4);
      const f32x4 b0 = *(const f32x4*)(p.cm_ln_b + l * 512 + 8 * lane), b1 = *(const f32x4*)(p.cm_ln_b + l * 512 + 8 * lane + 4);
#pragma unroll
      for (int j = 0; j < 4; ++j) { lg[j] = g0[j]; lg[4 + j] = g1[j]; lb[j] = b0[j]; lb[4 + j] = b1[j]; } }
    float cw[2][31], cbias[2];
    { const int c = tid & 255;
#pragma unroll
      for (int ch = 0; ch < 2; ++ch) { cbias[ch] = p.cm_conv_b[l * 512 + 256 * ch + c];
#pragma unroll
          for (int j = 0; j < 31; ++j) cw[ch][j] = p.cm_conv_w[(size_t)(l * 31 + j) * 512 + 256 * ch + c]; } }
    u32x4 sa[4], sb[4], sgt[4];
#define CONF_LOADS(sub_, ch_) do { _Pragma("unroll") for (int it = 0; it < 4; ++it) { const int i = tid + 512 * it; const int ri = i >> 5, c8 = i & 31; const int t = 32 * (sub_) - 15 + ri; const int pos = pos0 + t; \
        const bool ok = (i < 62 * 32) && pos >= 0 && pos < S; const bf16_t* hr = H + (size_t)(row0 + (ok ? t : 0)) * DIN + 256 * (ch_) + 8 * c8; sa[it] = *(const u32x4*)(hr + C_BA); sb[it] = *(const u32x4*)(hr + C_BB); } } while (0)
    CONF_LOADS(0, 0);
#pragma unroll 1
    for (int sub = 0; sub < 4; ++sub) { const int t0 = 32 * sub;
#pragma unroll
        for (int ch = 0; ch < 2; ++ch) {
#pragma unroll
            for (int it = 0; it < 4; ++it) { const int i = tid + 512 * it;
                const int ri = i >> 5, c8 = i & 31; const int t = t0 - 15 + ri; const int pos = pos0 + t;
                const bool ok = (i < 62 * 32) && pos >= 0 && pos < S;
                float a[8], bq[8], gv[8]; unpack8(sa[it], a); unpack8(sb[it], bq);
#pragma unroll
                for (int j = 0; j < 8; ++j) gv[j] = ok ? a[j] * bq[j] : 0.f;
                if (i < 62 * 32) { *(LAS f32x4*)(gbuf + ri * 256 + 8 * c8) = (f32x4){gv[0], gv[1], gv[2], gv[3]}; *(LAS f32x4*)(gbuf + ri * 256 + 8 * c8 + 4) = (f32x4){gv[4], gv[5], gv[6], gv[7]}; } }
            if (ch == 0) CONF_LOADS(sub, 1);
            else { if (sub < 3) CONF_LOADS(sub + 1, 0);
#pragma unroll
                for (int i = 0; i < 4; ++i) sgt[i] = *(const u32x4*)(H + (size_t)(row0 + t0 + 4 * wave + i) * DIN + C_BG + 8 * lane); }
            __syncthreads();
            { const int c = tid & 255, tg = tid >> 8, chn = 256 * ch + c;
                const float bias = cbias[ch];
                float acc[16];
#pragma unroll
                for (int tt = 0; tt < 16; ++tt) acc[tt] = bias;
#pragma unroll
                for (int i = 0; i < 46; ++i) { const float val = gbuf[(16 * tg + i) * 256 + c];
#pragma unroll
                    for (int tt = 0; tt < 16; ++tt) { const int j = i - tt; if (j >= 0 && j < 31) acc[tt] += cw[ch][j] * val; } }
#pragma unroll
                for (int tt = 0; tt < 16; ++tt) cbuf[(16 * tg + tt) * 512 + chn] = acc[tt]; }
            __syncthreads();
        }
#pragma unroll
        for (int i = 0; i < 4; ++i) { const int tk = 4 * wave + i;
            const f32x4 c0 = *(const LAS f32x4*)(cbuf + tk * 512 + 8 * lane), c1 = *(const LAS f32x4*)(cbuf + tk * 512 + 8 * lane + 4);
            float v[8] = {c0[0], c0[1], c0[2], c0[3], c1[0], c1[1], c1[2], c1[3]};
            float sum = 0.f;
#pragma unroll
            for (int j = 0; j < 8; ++j) sum += v[j];
            const float mean = wave_sum(sum) * (1.0f / 512.0f);
            float q = 0.f;
#pragma unroll
            for (int j = 0; j < 8; ++j) { v[j] -= mean; q += v[j] * v[j]; }
            const float rstd = rsqrtf(wave_sum(q) * (1.0f / 512.0f) + LN_EPS);
            const size_t row = (size_t)(row0 + t0 + tk);
            float gt[8]; unpack8(sgt[i], gt);
            const float ysc = ((const LAS float*)(lds + LDS_YSC))[t0 + tk];
#pragma unroll
            for (int j = 0; j < 8; ++j) { const float yv = v[j] * rstd * lg[j] + lb[j]; v[j] = ysc * silu_f(yv) * gt[j]; }
            *(u32x4*)(Y + row * DM + 512 + 8 * lane) = pack8(v); }
    }
#undef CONF_LOADS
}

constexpr int KP = 72, VP = 80, NKT = 18;
template <bool INTERIOR> __device__ __forceinline__ float attn_scores(f32x4 (&sacc)[NKT], float basef, float cminf, float cmaxf, float slope2) {
    float mx = -3.0e38f;
#pragma unroll
    for (int kt = 0; kt < NKT; ++kt)
#pragma unroll
        for (int jj = 0; jj < 4; ++jj) { const float c = (float)(16 * kt + jj); const float dist = fabsf(basef - c);
            float sc = sacc[kt][jj] * (0.125f * LOG2E) - slope2 * dist;
            if (!INTERIOR || kt < 2 || kt > 15) { const bool valid = (c >= cminf) && (c <= cmaxf); sc = valid ? sc : -1.0e30f; }
            sacc[kt][jj] = sc; mx = fmaxf(mx, sc); }
    return mx;
}
template <bool INTERIOR> __device__ __forceinline__ void mixer_attn(const P& p, int l, int row0, int pos0, int S, LAS unsigned char* lds) {
    int tid = threadIdx.x; asm volatile("" : "+v"(tid)); const int wave = tid >> 6, lane = tid & 63;
    const bf16_t* H = (const bf16_t*)(p.ws + WS_H); bf16_t* Y = (bf16_t*)(p.ws + WS_Y);
    LAS bf16_t* Kb = (LAS bf16_t*)lds;
    LAS bf16_t* Vb = (LAS bf16_t*)(lds + 384 * KP * 2);
    const int rq = lane & 15, q4 = lane >> 4, qq = (lane >> 2) & 3, pp = lane & 3;
#pragma unroll 1
    for (int g = 0; g < 2; ++g) {
        __syncthreads();
#pragma unroll
        for (int it = 0; it < 6; ++it) { const int i = tid + 512 * it; const int kk = i >> 3, c8 = i & 7; const int pos = pos0 - 128 + kk;
            const bool ok = pos >= 0 && pos < S;
            const bf16_t* hr = H + (size_t)(row0 + (ok ? kk - 128 : 0)) * DIN + 64 * g + 8 * c8;
            u32x4 kv = *(const u32x4*)(hr + C_K), vv = *(const u32x4*)(hr + C_V);
            const u32x4 zz = (u32x4){0u, 0u, 0u, 0u}; kv = ok ? kv : zz; vv = ok ? vv : zz;
            *(LAS u32x4*)(Kb + kk * KP + 8 * c8) = kv; *(LAS u32x4*)(Vb + kk * VP + 8 * c8) = vv; }
        const int head = 4 * g + (wave >> 1), qh = wave & 1;
        bf16x8 Qn[2];
        { const bf16_t* qp = H + (size_t)(row0 + 64 * qh + rq) * DIN + C_Q + 64 * head + 8 * q4; Qn[0] = *(const bf16x8*)qp; Qn[1] = *(const bf16x8*)(qp + 32); }
        const float slope2 = ex2(-(float)(head + 1)) * LOG2E;
        const float sink2 = p.attn_sink[l * 8 + head] * LOG2E;
        __syncthreads();
#pragma unroll 1
        for (int pass = 0; pass < 4; ++pass) { const int q0 = 64 * qh + 16 * pass;
            bf16x8 Qf[2]; Qf[0] = Qn[0]; Qf[1] = Qn[1];
            if (pass < 3) { const bf16_t* qp = H + (size_t)(row0 + q0 + 16 + rq) * DIN + C_Q + 64 * head + 8 * q4; Qn[0] = *(const bf16x8*)qp; Qn[1] = *(const bf16x8*)(qp + 32); }
            u32x2 gts[4];
#pragma unroll
            for (int dt = 0; dt < 4; ++dt) gts[dt] = *(const u32x2*)(H + (size_t)(row0 + q0 + rq) * DIN + C_CG + 64 * head + 16 * dt + 4 * q4);
            int t0k = q0 >> 4; if (t0k > 6) t0k = 6;
            const int kb0 = 16 * t0k;
            f32x4 sacc[NKT];
            const LAS bf16_t* kbase = Kb + (kb0 + rq) * KP + 8 * q4;
#pragma unroll
            for (int kt = 0; kt < NKT; ++kt) { const LAS bf16_t* kp = kbase + kt * (16 * KP);
                const bf16x8 k0 = *(const LAS bf16x8*)kp, k1 = *(const LAS bf16x8*)(kp + 32);
                f32x4 a = (f32x4){0.f, 0.f, 0.f, 0.f};
                a = __builtin_amdgcn_mfma_f32_16x16x32_bf16(k0, Qf[0], a, 0, 0, 0); a = __builtin_amdgcn_mfma_f32_16x16x32_bf16(k1, Qf[1], a, 0, 0, 0); sacc[kt] = a; }
            const int basei = 128 + q0 + rq - kb0 - 4 * q4;
            const int loi = -(pos0 - 128 + kb0 + 4 * q4), hii = loi + S - 1;
            const int cmin_i = max(loi, basei - 128), cmax_i = min(hii, basei + 128);
            const float basef = (float)basei, cminf = (float)cmin_i, cmaxf = (float)cmax_i;
            float mx = attn_scores<INTERIOR>(sacc, basef, cminf, cmaxf, slope2);
            mx = fmaxf(mx, __shfl_xor(mx, 16)); mx = fmaxf(mx, __shfl_xor(mx, 32));
            const float m2 = fmaxf(mx, sink2);
            float sum = 0.f;
#pragma unroll
            for (int kt = 0; kt < NKT; ++kt)
#pragma unroll
                for (int jj = 0; jj < 4; ++jj) { const float e = ex2(sacc[kt][jj] - m2); sacc[kt][jj] = e; sum += e; }
            sum += __shfl_xor(sum, 16); sum += __shfl_xor(sum, 32);
            const float inv = 1.0f / (sum + ex2(sink2 - m2));
            f32x4 o[4];
#pragma unroll
            for (int dt = 0; dt < 4; ++dt) o[dt] = (f32x4){0.f, 0.f, 0.f, 0.f};
            const LAS bf16_t* vbase = Vb + (kb0 + 4 * q4 + qq) * VP + 4 * pp;
#pragma unroll
            for (int s = 0; s < NKT / 2; ++s) {
                const f32x4 e0 = sacc[2 * s] * inv, e1 = sacc[2 * s + 1] * inv;
                u32x4 pw; pw.x = pk2(e0[0], e0[1]); pw.y = pk2(e0[2], e0[3]); pw.z = pk2(e1[0], e1[1]); pw.w = pk2(e1[2], e1[3]);
                const bf16x8 pf = __builtin_bit_cast(bf16x8, pw);
#pragma unroll
                for (int dt = 0; dt < 4; ++dt) { const LAS bf16_t* vp = vbase + s * (32 * VP) + 16 * dt;
                    const s16x4 lo = __builtin_amdgcn_ds_read_tr16_b64_v4i16((LAS s16x4*)vp);
                    const s16x4 hi = __builtin_amdgcn_ds_read_tr16_b64_v4i16((LAS s16x4*)(vp + 16 * VP));
                    const bf16x8 vf = {lo[0], lo[1], lo[2], lo[3], hi[0], hi[1], hi[2], hi[3]};
                    o[dt] = __builtin_amdgcn_mfma_f32_16x16x32_bf16(vf, pf, o[dt], 0, 0, 0); }
            }
            { const size_t row = (size_t)(row0 + q0 + rq); const float ysc = ((const LAS float*)(lds + LDS_YSC))[q0 + rq];
#pragma unroll
                for (int dt = 0; dt < 4; ++dt) { const int chn = 64 * head + 16 * dt + 4 * q4;
                    const float g0 = bflo(gts[dt].x), g1 = bfhi(gts[dt].x), g2 = bflo(gts[dt].y), g3 = bfhi(gts[dt].y);
                    u32x2 w; w.x = pk2(ysc * o[dt][0] * g0, ysc * o[dt][1] * g1); w.y = pk2(ysc * o[dt][2] * g2, ysc * o[dt][3] * g3);
                    *(u32x2*)(Y + row * DM + 1024 + chn) = w; } }
        }
    }
}

#define SC_LOADP(dst, t_) do { const int _t = (t_); const int _pos = pos0 + _t; const bool _ok = _pos >= 0 && _pos < S; \
        const bf16_t* _hr = H + (size_t)(row0 + (_ok ? _t : 0)) * DIN + c0; const u32x4 _rc = *(const u32x4*)(_hr + C_DC), _rx = *(const u32x4*)(_hr + C_DX); float _c[8], _x[8]; unpack8(_rc, _c); unpack8(_rx, _x); \
        _Pragma("unroll") for (int _j = 0; _j < 8; ++_j) dst[_j] = _ok ? _c[_j] * _x[_j] : 0.f; } while (0)
__device__ __forceinline__ void mixer_sconv(const P& p, int l, int row0, int pos0, int S, LAS unsigned char* lds) {
    int tid = threadIdx.x; asm volatile("" : "+v"(tid)); const int wave = tid >> 6, lane = tid & 63, c0 = 8 * lane;
    const bf16_t* H = (const bf16_t*)(p.ws + WS_H); bf16_t* Y = (bf16_t*)(p.ws + WS_Y);
    float w0[8], w1[8], w2[8];
    { const float* wp = p.sc_conv_w + (size_t)l * 3 * 512 + c0;
#pragma unroll
      for (int j = 0; j < 8; ++j) { w0[j] = wp[j]; w1[j] = wp[512 + j]; w2[j] = wp[1024 + j]; } }
    const int tb = 16 * wave;
    float prev[8], cur[8];
    u32x4 rcA[2], rxA[2], rbA[2], rgA[2], rcB[2], rxB[2], rbB[2], rgB[2], rcC[2], rxC[2], rbC[2], rgC[2];
#define SC_BATCH(k_, rc, rx, rb, rg) do { _Pragma("unroll") for (int u = 0; u < 2; ++u) { const int t = tb + 2 * (k_) + u; const int pn1 = pos0 + t + 1; const bool okn = pn1 >= 0 && pn1 < S; \
        const bf16_t* hn = H + (size_t)(row0 + (okn ? t + 1 : 0)) * DIN + c0; rc[u] = *(const u32x4*)(hn + C_DC); rx[u] = *(const u32x4*)(hn + C_DX); \
        const bf16_t* hr = H + (size_t)(row0 + t) * DIN + c0; rb[u] = *(const u32x4*)(hr + C_DB); rg[u] = *(const u32x4*)(hr + C_DG); } } while (0)
#define SC_COMPUTE(k_, rc, rx, rb, rg) do { _Pragma("unroll") for (int u = 0; u < 2; ++u) { const int t = tb + 2 * (k_) + u; const int pn1 = pos0 + t + 1; const bool okn = pn1 >= 0 && pn1 < S; \
        float cc[8], xx[8], bv[8], gv[8], o[8]; unpack8(rc[u], cc); unpack8(rx[u], xx); unpack8(rb[u], bv); unpack8(rg[u], gv); const float ysc = ((const LAS float*)(lds + LDS_YSC))[t]; \
        _Pragma("unroll") for (int j = 0; j < 8; ++j) { const float nx = okn ? cc[j] * xx[j] : 0.f; const float cv = w0[j] * prev[j] + w1[j] * cur[j] + w2[j] * nx; o[j] = ysc * bv[j] * cv * gv[j]; prev[j] = cur[j]; cur[j] = nx; } \
        *(u32x4*)(Y + (size_t)(row0 + t) * DM + 1536 + c0) = pack8(o); } } while (0)
    SC_BATCH(0, rcA, rxA, rbA, rgA); SC_BATCH(1, rcB, rxB, rbB, rgB);
    SC_LOADP(prev, tb - 1); SC_LOADP(cur, tb);
    SC_BATCH(2, rcC, rxC, rbC, rgC); SC_COMPUTE(0, rcA, rxA, rbA, rgA);
    SC_BATCH(3, rcA, rxA, rbA, rgA); SC_COMPUTE(1, rcB, rxB, rbB, rgB);
    SC_BATCH(4, rcB, rxB, rbB, rgB); SC_COMPUTE(2, rcC, rxC, rbC, rgC);
    SC_BATCH(5, rcC, rxC, rbC, rgC); SC_COMPUTE(3, rcA, rxA, rbA, rgA);
    SC_BATCH(6, rcA, rxA, rbA, rgA); SC_COMPUTE(4, rcB, rxB, rbB, rgB);
    SC_BATCH(7, rcB, rxB, rbB, rgB); SC_COMPUTE(5, rcC, rxC, rbC, rgC);
    SC_COMPUTE(6, rcA, rxA, rbA, rgA); SC_COMPUTE(7, rcB, rxB, rbB, rgB);
#undef SC_BATCH
#undef SC_COMPUTE
}

__device__ __forceinline__ void phase_mixers(const P& p, int l, LAS unsigned char* lds) {
    for (int blk = blockIdx.x; blk < MTOK / 128; blk += gridDim.x) {
        const int row0 = blk * 128; int pos0, S; seq_of_row(row0, pos0, S);
        __syncthreads();
        if (threadIdx.x < 128) { float sc = 1.0f / ALPHA;
            if (l > 0) { float mean, rstd; row_mean_rstd((const float*)(p.ws + WS_STATS) + (size_t)(l - 1) * MTOK * 2, row0 + (int)threadIdx.x, mean, rstd); sc = 1.0f / (ALPHA * rstd); }
            ((LAS float*)(lds + LDS_YSC))[threadIdx.x] = sc; }
        __syncthreads();
        mixer_sgu(p, l, row0, lds);
#ifdef PROBE_SGU2
        __syncthreads(); mixer_sgu(p, l, row0, lds);
#endif
        __syncthreads();
        mixer_conf(p, l, row0, pos0, S, lds);
#ifdef PROBE_CONF2
        __syncthreads(); mixer_conf(p, l, row0, pos0, S, lds);
#endif
        if ((pos0 >= 128) && (pos0 + 256 <= S)) mixer_attn<true>(p, l, row0, pos0, S, lds); else mixer_attn<false>(p, l, row0, pos0, S, lds);
        mixer_sconv(p, l, row0, pos0, S, lds);
    }
}

__device__ __forceinline__ void phase_final_ln(const P& p) {
    int tid = threadIdx.x; asm volatile("" : "+v"(tid)); const int wave = tid >> 6, lane = tid & 63;
    const int l = NLAYER - 1; const float* st = (const float*)(p.ws + WS_STATS) + (size_t)l * MTOK * 2;
    f32x4 gg[8], bb[8];
#pragma unroll
    for (int j = 0; j < 8; ++j) { gg[j] = *(const f32x4*)(p.post_ln_g + l * DM + 4 * lane + 256 * j); bb[j] = *(const f32x4*)(p.post_ln_b + l * DM + 4 * lane + 256 * j); }
    {
        u32x2 hv[2][8]; const int rstep = gridDim.x * 16; int row = (blockIdx.x * 8 + wave) * 2;
#define FLN_LOADS(row_) do { const bf16_t* zs = (const bf16_t*)(p.ws + WS_XB) + (size_t)(row_) * DM + 4 * lane; _Pragma("unroll") for (int rr = 0; rr < 2; ++rr) _Pragma("unroll") for (int j = 0; j < 8; ++j) hv[rr][j] = *(const u32x2*)(zs + (size_t)rr * DM + 256 * j); } while (0)
        if (row < MTOK) FLN_LOADS(row);
        for (; row < MTOK; row += rstep) {
            float* zr = p.out + (size_t)row * DM + 4 * lane;
            f32x4 v[2][8];
#pragma unroll
            for (int rr = 0; rr < 2; ++rr)
#pragma unroll
                for (int j = 0; j < 8; ++j) { const f16x4e hq = __builtin_bit_cast(f16x4e, hv[rr][j]); v[rr][j] = (f32x4){(float)hq[0], (float)hq[1], (float)hq[2], (float)hq[3]}; }
            float mean[2], rstd[2]; row_mean_rstd(st, row, mean[0], rstd[0]); row_mean_rstd(st, row + 1, mean[1], rstd[1]);
            if (row + rstep < MTOK) FLN_LOADS(row + rstep);
#pragma unroll
            for (int rr = 0; rr < 2; ++rr)
#pragma unroll
                for (int j = 0; j < 8; ++j) *(f32x4*)(zr + (size_t)rr * DM + 256 * j) = (v[rr][j] - mean[rr]) * rstd[rr] * gg[j] + bb[j];
        }
#undef FLN_LOADS
    }
}

__global__ void __launch_bounds__(512, 2) mega(P p_arg) {
    extern __shared__ __attribute__((aligned(16))) unsigned char smem[];
    LAS unsigned char* lds = (LAS unsigned char*)smem;
    cg::grid_group grid = cg::this_grid();
    const KArgPtr kp = (KArgPtr)__builtin_amdgcn_kernarg_segment_ptr();
    const int ph_lo = p_arg.ph_lo, ph_hi = p_arg.ph_hi;
    unsigned* barw = (unsigned*)(p_arg.ws + WS_BAR);
#define RUN(k) (ph_lo <= (k) && (k) < ph_hi)
    volatile LAS unsigned* barst = (volatile LAS unsigned*)(lds + LDS_BARST);
    XcdBarrier xb; xb.bar = barw; xb.x = 0; xb.st = barst;
    if (threadIdx.x < 2) barst[threadIdx.x] = 0u;
    __syncthreads();
    if (MK_COOP) xb = xcd_barrier_post(barw, barst);
#define SEAM(k) do { if (MK_COOP && RUN(k) && RUN((k) + 1)) { if ((k) == 0) grid.sync(); xcd_barrier(xb); } } while (0)
    if (RUN(0)) { const P p = load_params(kp); phase_prep(p, lds);
#ifdef PROBE_PREP2
        __syncthreads(); phase_prep(p, lds);
#endif
        SEAM(0); }
#pragma unroll 1
    for (int l = 0; l < NLAYER; ++l) {
        const int k = 1 + 3 * l;
        if (RUN(k)) {
            const P p = load_params(kp);
            pg8::Gemm g{(const bf16_t*)(p.ws + WS_XB), (const bf16_t*)(p.ws + WS_WIN) + (size_t)l * DIN * DM, MTOK, DIN, DM, (const bf16_t*)(p.ws + WS_XB), (const bf16_t*)(p.ws + WS_BI), 0};
            EpiH E{kp, l};
#ifdef PROBE_G1X2
            Order2 So; So.init(MTOK, DIN, gridDim.x, blockIdx.x);
            __syncthreads();
            pg8::gemm_phase<EpiH, Order2, false>(lds, g, So, E, nullptr);
#else
            pg8::StaticOrder So; So.init(MTOK, DIN, gridDim.x, blockIdx.x);
            __syncthreads();
            pg8::gemm_phase<EpiH, pg8::StaticOrder, false>(lds, g, So, E, nullptr);
            if (defer_prep() && l + 1 < NLAYER && blockIdx.x >= 128) { __syncthreads(); prep_weights(p, lds, l + 1, l + 2, 0, 1600, (int)blockIdx.x - 128, 128); }
#endif
            SEAM(k);
        }
        if (RUN(k + 1)) { const P p = load_params(kp); phase_mixers(p, l, lds);
#ifdef PROBE_MIX2
            __syncthreads(); phase_mixers(p, l, lds);
#endif
            SEAM(k + 1); }
        if (RUN(k + 2)) {
            const P p = load_params(kp);
            pg8::Gemm g{(const bf16_t*)(p.ws + WS_Y), (const bf16_t*)(p.ws + WS_WOUT) + (size_t)l * DM * DM, MTOK, DM, DM, (const bf16_t*)(p.ws + WS_XB), (const bf16_t*)(p.ws + WS_BI), PROBE_NTE};
            pg8::StaticOrder So; So.init(MTOK, DM, gridDim.x, blockIdx.x);
            EpiZ E{kp, l};
            __syncthreads();
            pg8::gemm_phase<EpiZ, pg8::StaticOrder, false>(lds, g, So, E, nullptr);
            SEAM(k + 2);
        }
    }
    if (RUN(NPHASE - 1)) { const P p = load_params(kp); phase_final_ln(p); }
#undef RUN
#undef SEAM
}

extern "C" void kernel_launch(void* const* d_in, const int* in_sizes, int n_in, void* d_out, int out_size, void* d_ws, size_t ws_size, hipStream_t stream) {
    static int grid_blocks = 0;
    if (grid_blocks == 0) {
        if (n_in != 16 || out_size != MTOK * DM || ws_size < WS_END2) { fprintf(stderr, "kernel_launch: unexpected shapes (n_in %d out %d ws %zu need %zu)\n", n_in, out_size, ws_size, (size_t)WS_END2); grid_blocks = -1; return; }
        int dev = 0, cus = 0, per_cu = 0;
        (void)hipGetDevice(&dev); (void)hipDeviceGetAttribute(&cus, hipDeviceAttributeMultiprocessorCount, dev);
        if (hipFuncSetAttribute((const void*)mega, hipFuncAttributeMaxDynamicSharedMemorySize, LDS_BYTES) != hipSuccess) { fprintf(stderr, "kernel_launch: hipFuncSetAttribute failed\n"); grid_blocks = -1; return; }
        if (hipOccupancyMaxActiveBlocksPerMultiprocessor(&per_cu, (const void*)mega, 512, LDS_BYTES) != hipSuccess || per_cu < 1) per_cu = 1;
        (void)hipGetLastError();
        if (cus <= 0) cus = 256;
        grid_blocks = cus * per_cu;
    }
    if (grid_blocks < 0) return;
    P p{};
    p.x_prompt = (const float*)d_in[0]; p.x_sample = (const float*)d_in[1]; p.w_in = (const float*)d_in[2]; p.w_out = (const float*)d_in[3];
    p.sgu_ln_g = (const float*)d_in[4]; p.sgu_ln_b = (const float*)d_in[5]; p.sgu_w = (const float*)d_in[6]; p.sgu_b = (const float*)d_in[7];
    p.cm_conv_w = (const float*)d_in[8]; p.cm_conv_b = (const float*)d_in[9]; p.cm_ln_g = (const float*)d_in[10]; p.cm_ln_b = (const float*)d_in[11];
    p.attn_sink = (const float*)d_in[12]; p.sc_conv_w = (const float*)d_in[13]; p.post_ln_g = (const float*)d_in[14]; p.post_ln_b = (const float*)d_in[15];
    p.out = (float*)d_out; p.ws = (unsigned char*)d_ws;
    if (hipMemsetAsync((char*)d_ws + WS_CTL, 0, CTL_BYTES, stream) != hipSuccess) { fprintf(stderr, "kernel_launch: memset failed\n"); return; }
#if MK_COOP
    p.ph_lo = 0; p.ph_hi = NPHASE;
    void* args[] = {&p};
    hipError_t e = hipLaunchCooperativeKernel((const void*)mega, dim3(grid_blocks), dim3(512), args, LDS_BYTES, stream);
    if (e != hipSuccess) fprintf(stderr, "cooperative launch failed: %s (grid %d)\n", hipGetErrorString(e), grid_blocks);
#else
    for (int k = 0; k < NPHASE; ++k) { p.ph_lo = k; p.ph_hi = k + 1; hipLaunchKernelGGL(mega, dim3(grid_blocks), dim3(512), LDS_BYTES, stream, p); }
#endif
}
```

```cpp
#include <hip/hip_runtime.h>
#include <hip/hip_cooperative_groups.h>
#include <cstdio>
namespace cg = cooperative_groups;
namespace pg8 {
#define PG8_LAS __attribute__((address_space(3)))
typedef unsigned short bf16_t;
typedef short bf16x8 __attribute__((ext_vector_type(8)));
typedef float f32x4 __attribute__((ext_vector_type(4)));
typedef unsigned u32x4 __attribute__((ext_vector_type(4)));
constexpr int BM = 256, BK = 64, HALF = 128, HTB = HALF * BK * 2  , STAGE_BYTES = 8 * HTB, NXCD = 8, WGM = 4;

__host__ __device__ __forceinline__ int lds_byte(int r, int c) { const int st = (r >> 4) * 2 + (c >> 5), rr = r & 15, cc = c & 31, ob = rr * 64 + cc * 2; return st * 1024 + (ob ^ (((ob >> 9) & 1) << 5)); }
__host__ __device__ __forceinline__ void stage_rc(int b, int& R, int& C) { const int st = b / 1024, sb = b % 1024, swz = sb ^ (((sb >> 9) & 1) << 5); R = (st >> 1) * 16 + swz / 64; C = (st & 1) * 32 + (swz % 64) / 2; }
__host__ __device__ __forceinline__ int perm32(int rho) { const int n = rho >> 4, i = rho & 15; return 8 * (i >> 2) + 4 * n + (i & 3); }

struct Unit { int pm, pn; };
struct Gemm { const bf16_t* A; const bf16_t* Bt; int M, N, K; const bf16_t* A2; const bf16_t* B2; int nte; };

struct StaticOrder {
    int nM, nN, nwg, G, c;
    __host__ __device__ void init(int M, int N, int G_, int c_) { nM = M / BM; nN = N / BM; nwg = nM * nN; G = G_; c = c_; }
    __host__ __device__ bool next(int i, Unit& u) const {
        const long L = (long)i * G + c; if (L >= nwg) return false;
        int wgid = (int)L; { const int q = nwg / NXCD, r = nwg % NXCD, xcd = wgid % NXCD, off = wgid / NXCD; wgid = (xcd < r ? xcd * (q + 1) : r * (q + 1) + (xcd - r) * q) + off; }
        const int nig = WGM * nN, gid = wgid / nig, fm = gid * WGM, gsz = (nM - fm) < WGM ? (nM - fm) : WGM;
        u.pm = fm + ((wgid % nig) % gsz); u.pn = (wgid % nig) / gsz; return true;
    }
    __device__ __forceinline__ void a_ready(const Unit&) const {}
    __device__ __forceinline__ void done(const Unit&) const {}
};

__device__ __forceinline__ unsigned cvt_pk_bf16(float lo, float hi) { unsigned r; asm("v_cvt_pk_bf16_f32 %0, %1, %2" : "=v"(r) : "v"(lo), "v"(hi)); return r; }
typedef float f32x2 __attribute__((ext_vector_type(2)));
__device__ __forceinline__ f32x2 gelu_pk(f32x2 v) {
    const f32x2 av = __builtin_elementwise_abs(v), d = av * 0.2316418882f + 1.0f;
    f32x2 t; t.x = __builtin_amdgcn_rcpf(d.x); t.y = __builtin_amdgcn_rcpf(d.y);
    f32x2 q = t * 0.5307027145f + (-0.7265760135f); q = q * t + 0.7107068705f; q = q * t + (-0.142248368f); q = q * t + 0.127414796f; q = q * t;
    const f32x2 s = (v * v) * (-0.72134752044f);
    f32x2 e; e.x = __builtin_amdgcn_exp2f(s.x); e.y = __builtin_amdgcn_exp2f(s.y);
    const f32x2 m = v * (q * e), r = v - m;
    f32x2 o; o.x = v.x < 0.f ? m.x : r.x; o.y = v.y < 0.f ? m.y : r.y; return o;
}

struct EpiF32 {
    static constexpr bool PERM = false, AFTER_DRAIN = false;
    float* C; int ldc; const float* bias;
    __device__ __forceinline__ void operator()(const f32x4 (&acc)[2][2][4][2], const Unit& u, int wr, int wc, int fr, int fq) const {
        const int row0 = u.pm * BM + wr * 64 + fr, col0 = u.pn * BM + wc * 32 + 4 * fq;
        f32x4 bv[2][2];
#pragma unroll
        for (int bj = 0; bj < 2; ++bj)
#pragma unroll
            for (int n = 0; n < 2; ++n) bv[bj][n] = bias ? *(const f32x4*)(bias + col0 + bj * HALF + n * 16) : (f32x4){0.f, 0.f, 0.f, 0.f};
#pragma unroll
        for (int ai = 0; ai < 2; ++ai)
#pragma unroll
            for (int m = 0; m < 4; ++m) { float* rowp = C + (size_t)(row0 + ai * HALF + m * 16) * ldc + col0;
#pragma unroll
                for (int bj = 0; bj < 2; ++bj)
#pragma unroll
                    for (int n = 0; n < 2; ++n) *(f32x4*)(rowp + bj * HALF + n * 16) = acc[ai][bj][m][n] + bv[bj][n]; }
    }
};
template <int ACT  > struct EpiBf16 {
    static constexpr bool PERM = true, AFTER_DRAIN = false;
    bf16_t* O; int ldc; const float* bias; int split_cols; size_t split_stride;
    __device__ __forceinline__ void operator()(const f32x4 (&acc)[2][2][4][2], const Unit& u, int wr, int wc, int fr, int fq) const {
        const int row0 = u.pm * BM + wr * 64 + fr; int colt = u.pn * BM; bf16_t* base = O;
        if (split_cols) { const int t = colt / split_cols; base += (size_t)t * split_stride; colt -= t * split_cols; }
        const int col0 = colt + wc * 32 + 8 * fq, bcol0 = u.pn * BM + wc * 32 + 8 * fq;
        f32x4 bv[2][2];
#pragma unroll
        for (int bj = 0; bj < 2; ++bj)
#pragma unroll
            for (int n = 0; n < 2; ++n) bv[bj][n] = bias ? *(const f32x4*)(bias + bcol0 + bj * HALF + 4 * n) : (f32x4){0.f, 0.f, 0.f, 0.f};
#pragma unroll
        for (int ai = 0; ai < 2; ++ai)
#pragma unroll
            for (int m = 0; m < 4; ++m) { bf16_t* rowp = base + (size_t)(row0 + ai * HALF + m * 16) * ldc + col0;
#pragma unroll
                for (int bj = 0; bj < 2; ++bj) { f32x4 v0 = acc[ai][bj][m][0] + bv[bj][0], v1 = acc[ai][bj][m][1] + bv[bj][1];
                    if (ACT == 1) { f32x2 a = gelu_pk((f32x2){v0[0], v0[1]}), b = gelu_pk((f32x2){v0[2], v0[3]}), c = gelu_pk((f32x2){v1[0], v1[1]}), d = gelu_pk((f32x2){v1[2], v1[3]});
                        v0 = (f32x4){a.x, a.y, b.x, b.y}; v1 = (f32x4){c.x, c.y, d.x, d.y}; }
                    if (ACT == 2) {
#pragma unroll
                        for (int j = 0; j < 4; ++j) { v0[j] = 0.5f * v0[j] * (1.0f + erff(v0[j] * 0.70710678f)); v1[j] = 0.5f * v1[j] * (1.0f + erff(v1[j] * 0.70710678f)); } }
                    u32x4 w; w.x = cvt_pk_bf16(v0[0], v0[1]); w.y = cvt_pk_bf16(v0[2], v0[3]); w.z = cvt_pk_bf16(v1[0], v1[1]); w.w = cvt_pk_bf16(v1[2], v1[3]);
                    *(u32x4*)(rowp + bj * HALF) = w; } }
    }
};

typedef _Float16 f16x8 __attribute__((ext_vector_type(8)));
template <bool F16> __device__ __forceinline__ f32x4 mma16(const bf16x8 a, const bf16x8 b, const f32x4 c) {
    if constexpr (F16) return __builtin_amdgcn_mfma_f32_16x16x32_f16(__builtin_bit_cast(f16x8, a), __builtin_bit_cast(f16x8, b), c, 0, 0, 0);
    else return __builtin_amdgcn_mfma_f32_16x16x32_bf16(a, b, c, 0, 0, 0);
}
template <class Epi, class Sched, bool STAMP = false>
__device__ __forceinline__ void gemm_phase(PG8_LAS unsigned char* lds, const Gemm g, const Sched& S, const Epi& E, unsigned long long* stamps) {
    int tid = threadIdx.x; asm volatile("" : "+v"(tid));
    const int wid = __builtin_amdgcn_readfirstlane(tid >> 6), lane = tid & 63, wr = wid >> 2, wc = wid & 3, fr = lane & 15, fq = lane >> 4;
    const int K = g.K, ntm = K / BK, nt = ntm + g.nte;
    int ts_lo = 0, ts_hi = 0, nts = 0; const unsigned long long rt_entry = STAMP ? (unsigned long long)wall_clock64() : 0ull;
#define PG8_STAMP() do { if (STAMP && wid == 0 && nts < 64) { const unsigned long long _c = (unsigned long long)clock64(); \
        ts_lo = (lane == nts) ? (int)(unsigned)_c : ts_lo; ts_hi = (lane == nts) ? (int)(unsigned)(_c >> 32) : ts_hi; ++nts; } } while (0)
    PG8_STAMP();
    unsigned voffA[2], voffB[2];
#pragma unroll
    for (int i = 0; i < 2; ++i) { int R, C; stage_rc(tid * 16 + i * 8192, R, C); const int Rb = Epi::PERM ? ((R & ~31) + perm32(R & 31)) : R;
        voffA[i] = (unsigned)(R * K + C) * 2u; voffB[i] = (unsigned)(Rb * K + C) * 2u; }
    const size_t kstep = (size_t)(BK * 2);
    const size_t hstep = (size_t)HALF * K * 2;
    const size_t tstep = 2 * hstep;
    const unsigned ldsw = (unsigned)wid * 1024u;
    const int aoff = lds_byte(wr * 64 + fr, fq * 8), boff = lds_byte(wc * 32 + fr, fq * 8);
#define PG8_SA(b, h) (((b) * 2 + (h)) * HTB)
#define PG8_SB(b, h) ((4 + (b) * 2 + (h)) * HTB)
#define PG8_STAGE(bufoff, gbase, voff) do { _Pragma("unroll") for (int _i = 0; _i < 2; ++_i) \
        __builtin_amdgcn_global_load_lds((const unsigned*)((const char*)(gbase) + (voff)[_i]), (PG8_LAS unsigned*)(lds + (bufoff) + ldsw + _i * 8192), 16, 0, 0); } while (0)
#define PG8_LDA(dst, b, h) do { _Pragma("unroll") for (int m = 0; m < 4; ++m) _Pragma("unroll") for (int k = 0; k < 2; ++k) dst[m][k] = *(const PG8_LAS bf16x8*)(lds + PG8_SA(b, h) + aoff + m * 2048 + k * 1024); } while (0)
#define PG8_LDB(dst, b, h) do { _Pragma("unroll") for (int n = 0; n < 2; ++n) _Pragma("unroll") for (int k = 0; k < 2; ++k) dst[n][k] = *(const PG8_LAS bf16x8*)(lds + PG8_SB(b, h) + boff + n * 2048 + k * 1024); } while (0)
#define PG8_MMA(ai, bj, At, Bt) do { __builtin_amdgcn_s_setprio(1); _Pragma("unroll") for (int m = 0; m < 4; ++m) _Pragma("unroll") for (int n = 0; n < 2; ++n) _Pragma("unroll") for (int k = 0; k < 2; ++k) \
        acc[ai][bj][m][n] = mma16<Epi::F16>(Bt[n][k], At[m][k], acc[ai][bj][m][n]); __builtin_amdgcn_s_setprio(0); } while (0)
#define PG8_WAIT_V(n) asm volatile("s_waitcnt vmcnt(" #n ")" ::: "memory")
#define PG8_WAIT_L(n) asm volatile("s_waitcnt lgkmcnt(" #n ")" ::: "memory")
#define PG8_BAR __builtin_amdgcn_s_barrier()
#define PG8_SCHED __builtin_amdgcn_sched_barrier(0)
    Unit cur, nxt; int ui = 0;
    if (!S.next(0, cur)) return;
    f32x4 acc[2][2][4][2];
#pragma unroll
    for (int a = 0; a < 2; ++a)
#pragma unroll
        for (int b = 0; b < 2; ++b)
#pragma unroll
            for (int m = 0; m < 4; ++m)
#pragma unroll
                for (int n = 0; n < 2; ++n) acc[a][b][m][n] = (f32x4){0.f, 0.f, 0.f, 0.f};
    bf16x8 At[4][2], B0[2][2], B1[2][2];
    const char* cA = (const char*)g.A + (size_t)cur.pm * tstep; const char* cB = (const char*)g.Bt + (size_t)cur.pn * tstep;
    const char* cA2 = (const char*)g.A2 + (size_t)cur.pm * tstep + (size_t)cur.pn * (BM * 2); const char* const cB2 = (const char*)g.B2;
#define PG8_TA(t_) ((t_) < ntm ? cA + (size_t)(t_) * kstep : cA2 + (size_t)((t_) - ntm) * kstep)
#define PG8_TB(t_) ((t_) < ntm ? cB + (size_t)(t_) * kstep : cB2 + (size_t)((t_) - ntm) * kstep)
    S.a_ready(cur);
    typename Epi::Pre pre; E.prefetch(pre, cur, wr, wc, lane);
    PG8_STAGE(PG8_SB(0, 0), cB, voffB); PG8_STAGE(PG8_SB(0, 1), cB + hstep, voffB); PG8_STAGE(PG8_SA(0, 0), cA, voffA); PG8_STAGE(PG8_SA(0, 1), cA + hstep, voffA);
    if (wr == 1) PG8_BAR;
    PG8_WAIT_V(2); PG8_BAR;
    PG8_STAGE(PG8_SB(1, 0), cB + kstep, voffB); PG8_STAGE(PG8_SA(1, 0), cA + kstep, voffA); PG8_STAGE(PG8_SB(1, 1), cB + hstep + kstep, voffB);
    PG8_WAIT_V(6); PG8_BAR;
    PG8_STAMP();
    for (;;) {
        const bool has_next = S.next(ui + 1, nxt);
        const char* nA = has_next ? (const char*)g.A + (size_t)nxt.pm * tstep : cA; const char* nB = has_next ? (const char*)g.Bt + (size_t)nxt.pn * tstep : cB;
        for (int t = 0; t < nt; t += 2) {
            const bool last = (t == nt - 2);
            const char* a1 = PG8_TA(t + 1);
            const char* a2 = last ? nA : PG8_TA(t + 2); const char* b2 = last ? nB : PG8_TB(t + 2);
            const char* a3 = a2 + kstep; const char* b3 = b2 + kstep;
            if (last && has_next) S.a_ready(nxt);
            PG8_LDB(B0, 0, 0); PG8_LDB(B1, 0, 1); PG8_SCHED; PG8_LDA(At, 0, 0); PG8_STAGE(PG8_SA(1, 1), a1 + hstep, voffA);
            PG8_WAIT_V(8); PG8_WAIT_L(0); PG8_BAR; PG8_MMA(0, 0, At, B0); PG8_MMA(0, 1, At, B1); PG8_BAR; PG8_SCHED;
            PG8_LDA(At, 0, 1); PG8_STAGE(PG8_SB(0, 0), b2, voffB); PG8_STAGE(PG8_SB(0, 1), b2 + hstep, voffB); PG8_STAGE(PG8_SA(0, 0), a2, voffA);
            PG8_WAIT_V(8); PG8_WAIT_L(0); PG8_BAR; PG8_MMA(1, 0, At, B0); PG8_MMA(1, 1, At, B1); PG8_BAR; PG8_SCHED;
            PG8_LDB(B0, 1, 0); PG8_LDB(B1, 1, 1); PG8_SCHED; PG8_LDA(At, 1, 0); PG8_STAGE(PG8_SA(0, 1), a2 + hstep, voffA);
            PG8_WAIT_V(8); PG8_WAIT_L(0); PG8_BAR; PG8_MMA(0, 0, At, B0); PG8_MMA(0, 1, At, B1); PG8_BAR; PG8_SCHED;
            PG8_LDA(At, 1, 1); PG8_STAGE(PG8_SB(1, 0), b3, voffB); PG8_STAGE(PG8_SB(1, 1), b3 + hstep, voffB); PG8_STAGE(PG8_SA(1, 0), a3, voffA);
            PG8_WAIT_V(8); PG8_WAIT_L(0); PG8_BAR; PG8_MMA(1, 0, At, B0); PG8_MMA(1, 1, At, B1); PG8_BAR; PG8_SCHED;
        }
        PG8_STAMP();
        if (wr == 0) PG8_BAR;
        if constexpr (!Epi::AFTER_DRAIN) { E(acc, cur, wr, wc, fr, fq, pre); if (has_next) E.prefetch(pre, nxt, wr, wc, lane); S.done(cur); }
        PG8_STAMP();
        if (!has_next) break;
#pragma unroll
        for (int a = 0; a < 2; ++a)
#pragma unroll
            for (int b = 0; b < 2; ++b)
#pragma unroll
                for (int m = 0; m < 4; ++m)
#pragma unroll
                    for (int n = 0; n < 2; ++n) acc[a][b][m][n] = (f32x4){0.f, 0.f, 0.f, 0.f};
        cur = nxt; cA = nA; cB = nB; cA2 = (const char*)g.A2 + (size_t)cur.pm * tstep + (size_t)cur.pn * (BM * 2); ++ui;
        if (wr == 1) PG8_BAR;
    }
    PG8_WAIT_V(0);
    PG8_BAR;
    if constexpr (Epi::AFTER_DRAIN) { E.fused(acc, cur, wr, wc, fr, fq, lds, wid, lane); S.done(cur); }
    PG8_STAMP();
    if (STAMP && wid == 0) { stamps[lane] = lane < nts ? (((unsigned long long)(unsigned)ts_hi << 32) | (unsigned)ts_lo) : 0ull;
        if (lane == 62) stamps[62] = rt_entry; if (lane == 63) stamps[63] = (unsigned long long)wall_clock64(); }
#undef PG8_STAMP
#undef PG8_TA
#undef PG8_TB
#undef PG8_SA
#undef PG8_SB
#undef PG8_STAGE
#undef PG8_LDA
#undef PG8_LDB
#undef PG8_MMA
#undef PG8_WAIT_V
#undef PG8_WAIT_L
#undef PG8_BAR
#undef PG8_SCHED
}
}

#ifdef PROBE_BAR3
#define PROBE_EXTRA_BAR xcd_barrier(xb); xcd_barrier(xb);
#else
#define PROBE_EXTRA_BAR
#endif
#ifndef PROBE_NTE
#define PROBE_NTE 4
#endif
#ifndef STREAM_F16
#define STREAM_F16 0
#endif
#ifndef MK_COOP
#define MK_COOP 1
#endif
#define LAS __attribute__((address_space(3)))
typedef unsigned short bf16_t;
typedef short bf16x8 __attribute__((ext_vector_type(8)));
typedef short s16x4 __attribute__((ext_vector_type(4)));
typedef float f32x4 __attribute__((ext_vector_type(4)));
typedef float f32x2 __attribute__((ext_vector_type(2)));
typedef unsigned u32x4 __attribute__((ext_vector_type(4)));
typedef unsigned u32x2 __attribute__((ext_vector_type(2)));

constexpr int MTOK = 32768, DM = 2048, DIN = 6400, NLAYER = 4;
constexpr int ROWS_PROMPT = 16384;
constexpr float LN_EPS = 1e-5f;
constexpr float ALPHA = 1.681792830507429f;
constexpr float LOG2E = 1.4426950408889634f;
constexpr int C_AU = 0, C_AV = 512, C_AG = 1024, C_BA = 1536, C_BB = 2048, C_BG = 2560, C_Q = 3072, C_K = 3584, C_V = 3712, C_CG = 3840,
              C_DB = 4352, C_DC = 4864, C_DX = 5376, C_DG = 5888;
constexpr size_t WS_WIN = 0;
constexpr size_t WS_WOUT = WS_WIN + (size_t)NLAYER * DIN * DM * 2;
constexpr size_t WS_XB = WS_WOUT + (size_t)NLAYER * DM * DM * 2;
constexpr size_t WS_Y = WS_XB + (size_t)MTOK * DM * 2;
constexpr size_t WS_H = WS_Y + (size_t)MTOK * DM * 2;
constexpr size_t WS_SGUW = WS_H + (size_t)MTOK * DIN * 2;
constexpr size_t WS_BI = WS_SGUW + (size_t)NLAYER * 4 * 128 * 128 * 2;
constexpr size_t WS_CTL = WS_BI + (size_t)256 * DM * 2;
constexpr size_t WS_BAR = WS_CTL;
constexpr size_t WS_CS = WS_BAR + 16384;
constexpr size_t WS_BW = WS_CS + (size_t)NLAYER * DIN * 4;
constexpr size_t WS_STATS = WS_BW + (size_t)NLAYER * DIN * 4;
constexpr size_t WS_END2 = WS_STATS + (size_t)NLAYER * MTOK * 2 * 4;
constexpr size_t CTL_BYTES = WS_END2 - WS_CTL;
constexpr int LDS_BYTES = 136 * 1024;
constexpr int LDS_BARST = LDS_BYTES - 16;
constexpr int NPHASE = 2 + 3 * NLAYER;
constexpr int LDS_YSC = 133120;

struct P {
    const float *x_prompt, *x_sample, *w_in, *w_out, *sgu_ln_g, *sgu_ln_b, *sgu_w, *sgu_b, *cm_conv_w, *cm_conv_b, *cm_ln_g, *cm_ln_b, *attn_sink, *sc_conv_w, *post_ln_g, *post_ln_b;
    float* out; unsigned char* ws; int ph_lo, ph_hi;
};

__device__ __forceinline__ float bflo(unsigned w) { return __uint_as_float(w << 16); }
__device__ __forceinline__ float bfhi(unsigned w) { return __uint_as_float(w & 0xffff0000u); }
__device__ __forceinline__ float bf1(bf16_t b) { return __uint_as_float(((unsigned)b) << 16); }
__device__ __forceinline__ unsigned pk2(float lo, float hi) { return pg8::cvt_pk_bf16(lo, hi); }
typedef _Float16 f16x2e __attribute__((ext_vector_type(2)));
typedef _Float16 f16x4e __attribute__((ext_vector_type(4)));
__device__ __forceinline__ unsigned pkh2e(float lo, float hi) { const f16x2e v = {(_Float16)lo, (_Float16)hi}; return __builtin_bit_cast(unsigned, v); }
__device__ __forceinline__ void unpack8(const u32x4 r, float (&v)[8]) {
    v[0] = bflo(r.x); v[1] = bfhi(r.x); v[2] = bflo(r.y); v[3] = bfhi(r.y); v[4] = bflo(r.z); v[5] = bfhi(r.z); v[6] = bflo(r.w); v[7] = bfhi(r.w); }
__device__ __forceinline__ u32x4 pack8(const float (&v)[8]) { u32x4 w; w.x = pk2(v[0], v[1]); w.y = pk2(v[2], v[3]); w.z = pk2(v[4], v[5]); w.w = pk2(v[6], v[7]); return w; }
__device__ __forceinline__ float ex2(float x) { return __builtin_amdgcn_exp2f(x); }
__device__ __forceinline__ float sigm_f(float x) { return __builtin_amdgcn_rcpf(1.0f + ex2(-x * LOG2E)); }
__device__ __forceinline__ float silu_f(float x) { return x * sigm_f(x); }
__device__ __forceinline__ float wave_sum(float v) { v += __shfl_xor(v, 32); v += __shfl_xor(v, 16); v += __shfl_xor(v, 8); v += __shfl_xor(v, 4); v += __shfl_xor(v, 2); v += __shfl_xor(v, 1); return v; }
__device__ __forceinline__ void seq_of_row(int row0, int& pos0, int& S) { if (row0 < ROWS_PROMPT) { S = 2048; pos0 = row0 & 2047; } else { S = 4096; pos0 = (row0 - ROWS_PROMPT) & 4095; } }

#define XB_TMO      128
#define XB_XCNT(j)  (256  + 64 * (j))
#define XB_XSUB(j)  (1280 + 64 * (j))
#define XB_XGEN(j)  (2304 + 64 * (j))
#define XB_TOP      3328
#define XB_TOPGEN   3392
#define XCD_BAR_WORDS 3456
#define XB_SPIN_CAP (1u << 18)

__device__ __forceinline__ unsigned xb_ld(unsigned* p)              { return __hip_atomic_load(p, __ATOMIC_RELAXED, __HIP_MEMORY_SCOPE_AGENT); }
__device__ __forceinline__ unsigned xb_add(unsigned* p, unsigned v) { return __hip_atomic_fetch_add(p, v, __ATOMIC_RELAXED, __HIP_MEMORY_SCOPE_AGENT); }
__device__ __forceinline__ unsigned xb_xcc_id() { return (unsigned)__builtin_amdgcn_s_getreg((3 << 11) | 20) & 0xFu; }
#define XB_SPIN(cond, bar) do { unsigned _sp = 0; while (cond) { __builtin_amdgcn_s_sleep(1); \
    if ((++_sp & 255u) == 0u) { if (xb_ld(&(bar)[XB_TMO])) break; if (_sp > XB_SPIN_CAP) { atomicAdd(&(bar)[XB_TMO], 1u); break; } } } } while (0)

struct XcdBarrier {
    unsigned* bar; unsigned x;
    volatile LAS unsigned* st;
};

__device__ __forceinline__ XcdBarrier xcd_barrier_post(unsigned* bar, volatile LAS unsigned* st) {
    XcdBarrier b; b.bar = bar; b.x = xb_xcc_id(); b.st = st;
    if (threadIdx.x == 0) (void)xb_add(&bar[XB_XCNT(b.x)], 1u);
    return b;
}
__device__ __forceinline__ void xcd_barrier_complete(unsigned* bar, unsigned x, unsigned& nloc, unsigned& nx) {
    const unsigned G = gridDim.x * gridDim.y * gridDim.z;
    unsigned sum, cnt, mine, sp = 0u;
    for (;;) {
        sum = 0u; cnt = 0u; mine = 0u;
#pragma unroll
        for (unsigned j = 0; j < 16; ++j) { const unsigned c = xb_ld(&bar[XB_XCNT(j)]); sum += c; cnt += (c > 0u) ? 1u : 0u; mine = (j == x) ? c : mine; }
        if (sum == G) break;
        __builtin_amdgcn_s_sleep(1);
        if ((++sp & 255u) == 0u) { if (xb_ld(&bar[XB_TMO])) break; if (sp > XB_SPIN_CAP) { atomicAdd(&bar[XB_TMO], 1u); break; } }
    }
    nloc = mine > 0u ? mine : 1u; nx = cnt > 0u ? cnt : 1u;
}

__device__ __forceinline__ void xcd_barrier(const XcdBarrier& b) {
    asm volatile("s_waitcnt vmcnt(0)" ::: "memory");
    __syncthreads();
    if (threadIdx.x == 0) {
        unsigned* bar = b.bar;
        __builtin_amdgcn_s_waitcnt(0);
        unsigned nloc = b.st[0], nx = b.st[1];
        if (nloc == 0u) { xcd_barrier_complete(bar, b.x, nloc, nx); b.st[0] = nloc; b.st[1] = nx; }
        const unsigned old = xb_add(&bar[XB_XSUB(b.x)], 1u);
        const unsigned gen = old / nloc;
        if (old + 1u == (gen + 1u) * nloc) {
            __builtin_amdgcn_fence(__ATOMIC_RELEASE, "agent");
            asm volatile("s_waitcnt vmcnt(0)" ::: "memory");
            const unsigned og = xb_add(&bar[XB_TOP], 1u);
            const unsigned tg = og / nx;
            if (og + 1u == (tg + 1u) * nx) xb_add(&bar[XB_TOPGEN], 1u);
            else XB_SPIN(xb_ld(&bar[XB_TOPGEN]) == tg, bar);
            __builtin_amdgcn_fence(__ATOMIC_ACQUIRE, "agent");
            xb_add(&bar[XB_XGEN(b.x)], 1u);
            asm volatile("s_waitcnt vmcnt(0)" ::: "memory");
        } else {
            XB_SPIN(xb_ld(&bar[XB_XGEN(b.x)]) == gen, bar);
            __builtin_amdgcn_fence(__ATOMIC_ACQUIRE, "agent");
            asm volatile("s_waitcnt vmcnt(0)" ::: "memory");
        }
    }
    __syncthreads();
}


struct OrderSh : pg8::StaticOrder { int sh; __device__ bool next(int i, pg8::Unit& u) const { return pg8::StaticOrder::next(i >> sh, u); } };
struct Order2 : pg8::StaticOrder { __device__ bool next(int i, pg8::Unit& u) const { return pg8::StaticOrder::next(i >> 1, u); } };
typedef const __attribute__((address_space(4))) P* KArgPtr;
__device__ __forceinline__ P load_params(KArgPtr kp) {
#if defined(__HIP_DEVICE_COMPILE__)
    asm volatile("" : "+s"(kp)); P r;
    r.x_prompt = kp->x_prompt; r.x_sample = kp->x_sample; r.w_in = kp->w_in; r.w_out = kp->w_out; r.sgu_ln_g = kp->sgu_ln_g; r.sgu_ln_b = kp->sgu_ln_b; r.sgu_w = kp->sgu_w; r.sgu_b = kp->sgu_b;
    r.cm_conv_w = kp->cm_conv_w; r.cm_conv_b = kp->cm_conv_b; r.cm_ln_g = kp->cm_ln_g; r.cm_ln_b = kp->cm_ln_b; r.attn_sink = kp->attn_sink; r.sc_conv_w = kp->sc_conv_w; r.post_ln_g = kp->post_ln_g; r.post_ln_b = kp->post_ln_b;
    r.out = kp->out; r.ws = kp->ws; r.ph_lo = kp->ph_lo; r.ph_hi = kp->ph_hi; return r;
#else
    return P{};
#endif
}
constexpr float FX_S1 = 16384.0f, FX_S2 = 4096.0f, FX_CS = 16777216.0f;
__device__ __forceinline__ void stats_decode(const f32x2 v, float& mean, float& rstd) {
    const int lo = __float_as_int(v.x); const unsigned hi = __float_as_uint(v.y) + (lo < 0 ? 1u : 0u);
    const float s1 = (float)lo * (1.0f / FX_S1), s2 = (float)hi * (1.0f / FX_S2);
    mean = s1 * (1.0f / DM); const float var = s2 * (1.0f / DM) - mean * mean; rstd = rsqrtf(var + LN_EPS); }
__device__ __forceinline__ void row_mean_rstd(const float* st, int row, float& mean, float& rstd) { stats_decode(*(const f32x2*)(st + 2 * (size_t)row), mean, rstd); }
__device__ __forceinline__ void mean_rstd_of(const f32x2 v, bool plain, float& mean, float& rstd) { float m, r; stats_decode(v, m, r); mean = plain ? 0.f : m; rstd = plain ? 1.f : r; }

struct EpiPre { f32x2 st[2]; f32x2 cv; };
struct EpiH {
    static constexpr bool PERM = true, AFTER_DRAIN = false, F16 = (STREAM_F16 != 0);
    typedef EpiPre Pre;
    KArgPtr kp; int l;
    __device__ __forceinline__ void prefetch(Pre& pre, const pg8::Unit& u, int wr, int wc, int lane) const {
        KArgPtr kq = kp; asm volatile("" : "+s"(kq)); unsigned char* const ws = kq->ws;
        const float* cs = (const float*)(ws + WS_CS) + l * DIN; const float* bw = (const float*)(ws + WS_BW) + l * DIN;
        const float* st = (const float*)(ws + WS_STATS) + (size_t)(l > 0 ? l - 1 : 0) * MTOK * 2;
        const int r = u.pm * 256 + wr * 64 + lane, c = u.pn * 256 + (lane >> 5) * 128 + wc * 32 + (lane & 31);
        pre.st[0] = *(const f32x2*)(st + 2 * (size_t)r); pre.st[1] = *(const f32x2*)(st + 2 * (size_t)(r + 128));
        pre.cv = (f32x2){(float)__float_as_int(cs[c]) * (1.0f / FX_CS), (float)__float_as_int(bw[c]) * (1.0f / FX_CS)};
    }
    __device__ __forceinline__ void operator()(const f32x4 (&acc)[2][2][4][2], const pg8::Unit& u, int wr, int wc, int fr, int fq, const Pre& pre) const {
        KArgPtr kq = kp; asm volatile("" : "+s"(kq)); unsigned char* const ws = kq->ws; const bool plain = (l == 0);
        bf16_t* O = (bf16_t*)(ws + WS_H);
        const int pn = u.pn; const int act = (pn == 4 || pn == 5 || pn == 10 || pn == 11 || pn == 15 || pn == 16 || pn == 23 || pn == 24) ? 1 : ((pn == 8 || pn == 9) ? 2 : 0);
        const int row0 = u.pm * 256 + wr * 64 + fr, col0 = u.pn * 256 + wc * 32 + 8 * fq;
        f32x4 c[2][2], w[2][2];
#pragma unroll
        for (int bj = 0; bj < 2; ++bj)
#pragma unroll
            for (int n = 0; n < 2; ++n)
#pragma unroll
                for (int j = 0; j < 4; ++j) { const int src = bj * 32 + 8 * fq + 4 * n + j; c[bj][n][j] = __shfl(pre.cv.x, src); w[bj][n][j] = __shfl(pre.cv.y, src); }
#pragma unroll
        for (int ai = 0; ai < 2; ++ai)
#pragma unroll
            for (int m = 0; m < 4; ++m) { const int row = row0 + ai * 128 + m * 16; const f32x2 sv = (f32x2){__shfl(pre.st[ai].x, m * 16 + fr), __shfl(pre.st[ai].y, m * 16 + fr)};
                float mean, rstd; mean_rstd_of(sv, plain, mean, rstd);
                const float mr = -mean * rstd; bf16_t* rowp = O + (size_t)row * DIN + col0;
#pragma unroll
                for (int bj = 0; bj < 2; ++bj) { f32x4 v0 = acc[ai][bj][m][0] * rstd + (c[bj][0] * mr + w[bj][0]), v1 = acc[ai][bj][m][1] * rstd + (c[bj][1] * mr + w[bj][1]);
                    if (act) {
#pragma unroll
                        for (int j = 0; j < 4; ++j) { const float s0 = sigm_f(v0[j]), s1 = sigm_f(v1[j]); v0[j] = (act == 1) ? v0[j] * s0 : s0; v1[j] = (act == 1) ? v1[j] * s1 : s1; } }
                    u32x4 o; o.x = pk2(v0[0], v0[1]); o.y = pk2(v0[2], v0[3]); o.z = pk2(v1[0], v1[1]); o.w = pk2(v1[2], v1[3]); *(u32x4*)(rowp + bj * 128) = o; } }
    }
};

typedef _Float16 f16x2 __attribute__((ext_vector_type(2)));
#if STREAM_F16
__device__ __forceinline__ unsigned pkh2(float lo, float hi) { return __builtin_bit_cast(unsigned, __builtin_amdgcn_cvt_pkrtz(lo, hi)); }
__device__ __forceinline__ f32x4 unpackh4(const u32x2 w) { const f16x2 a = __builtin_bit_cast(f16x2, w.x), b = __builtin_bit_cast(f16x2, w.y); return (f32x4){(float)a.x, (float)a.y, (float)b.x, (float)b.y}; }
#else
__device__ __forceinline__ unsigned pkh2(float lo, float hi) { return pk2(lo, hi); }
__device__ __forceinline__ f32x4 unpackh4(const u32x2 w) { return (f32x4){bflo(w.x), bfhi(w.x), bflo(w.y), bfhi(w.y)}; }
#endif

struct EpiZ {
    static constexpr bool PERM = true, AFTER_DRAIN = false, F16 = false;
    typedef EpiPre Pre;
    KArgPtr kp; int l;
    __device__ __forceinline__ void prefetch(Pre& pre, const pg8::Unit& u, int wr, int wc, int lane) const {
        KArgPtr kq = kp; asm volatile("" : "+s"(kq)); unsigned char* const ws = kq->ws; const int lp = l > 0 ? l - 1 : 0;
        const float* stp = (const float*)(ws + WS_STATS) + (size_t)lp * MTOK * 2; const float* g = kq->post_ln_g + lp * DM; const float* b = kq->post_ln_b + lp * DM;
        const int r = u.pm * 256 + wr * 64 + lane, c = u.pn * 256 + (lane >> 5) * 128 + wc * 32 + (lane & 31);
        pre.st[0] = *(const f32x2*)(stp + 2 * (size_t)r); pre.st[1] = *(const f32x2*)(stp + 2 * (size_t)(r + 128));
        pre.cv = (f32x2){g[c], b[c]};
    }
    __device__ __forceinline__ void operator()(const f32x4 (&acc)[2][2][4][2], const pg8::Unit& u, int wr, int wc, int fr, int fq, const Pre& pre) const {
        KArgPtr kq = kp; asm volatile("" : "+s"(kq)); const bool layer0 = (l == 0), lastl = (l == NLAYER - 1); const int lp = l > 0 ? l - 1 : 0;
        unsigned char* const ws = kq->ws; float* out = kq->out; bf16_t* XB = (bf16_t*)(ws + WS_XB);
        const float* stp = (const float*)(ws + WS_STATS) + (size_t)lp * MTOK * 2; float* stn = (float*)(ws + WS_STATS) + (size_t)l * MTOK * 2;
        const float* g = kq->post_ln_g + lp * DM; const float* b = kq->post_ln_b + lp * DM;
        const int row0 = u.pm * 256 + wr * 64 + fr, col0 = u.pn * 256 + wc * 32 + 8 * fq;
        f32x4 gv[2][2], bv[2][2]; f32x2 sv[8];
#pragma unroll
        for (int rg = 0; rg < 8; ++rg) sv[rg] = (f32x2){__shfl(pre.st[rg >> 2].x, (rg & 3) * 16 + fr), __shfl(pre.st[rg >> 2].y, (rg & 3) * 16 + fr)};
#pragma unroll
        for (int bj = 0; bj < 2; ++bj)
#pragma unroll
            for (int n = 0; n < 2; ++n) { f32x4 g4, b4;
#pragma unroll
                for (int j = 0; j < 4; ++j) { const int src = bj * 32 + 8 * fq + 4 * n + j; g4[j] = __shfl(pre.cv.x, src); b4[j] = __shfl(pre.cv.y, src); }
                gv[bj][n] = layer0 ? (f32x4){ALPHA, ALPHA, ALPHA, ALPHA} : g4 * ALPHA; bv[bj][n] = layer0 ? (f32x4){0.f, 0.f, 0.f, 0.f} : b4 * ALPHA; }
#pragma unroll
        for (int rg = 0; rg < 8; ++rg) {
            const int ai = rg >> 2, m = rg & 3;
            const int row = row0 + ai * 128 + m * 16; const size_t off = (size_t)row * DM + col0;
            float mean, rstd; mean_rstd_of(sv[rg], layer0, mean, rstd);
            bf16_t* dstb = XB + off; float* dst = out + off;
            float s1 = 0.f, s2 = 0.f;
#pragma unroll
            for (int bj = 0; bj < 2; ++bj) {
                const f32x4 z0 = (acc[ai][bj][m][0] - mean) * rstd * gv[bj][0] + bv[bj][0], z1 = (acc[ai][bj][m][1] - mean) * rstd * gv[bj][1] + bv[bj][1];
                u32x4 w; if (lastl) { w.x = pkh2e(z0[0], z0[1]); w.y = pkh2e(z0[2], z0[3]); w.z = pkh2e(z1[0], z1[1]); w.w = pkh2e(z1[2], z1[3]); }
                else { w.x = pk2(z0[0], z0[1]); w.y = pk2(z0[2], z0[3]); w.z = pk2(z1[0], z1[1]); w.w = pk2(z1[2], z1[3]); }
                *(u32x4*)(dstb + bj * 128) = w;
                s1 += ((z0[0] + z0[1]) + (z0[2] + z0[3])) + ((z1[0] + z1[1]) + (z1[2] + z1[3]));
                s2 += ((z0[0] * z0[0] + z0[1] * z0[1]) + (z0[2] * z0[2] + z0[3] * z0[3])) + ((z1[0] * z1[0] + z1[1] * z1[1]) + (z1[2] * z1[2] + z1[3] * z1[3])); }
            s1 += __shfl_xor(s1, 16); s1 += __shfl_xor(s1, 32); s2 += __shfl_xor(s2, 16); s2 += __shfl_xor(s2, 32);
            if (fq == 0) { const long long packed = (long long)(((unsigned long long)(unsigned)__float2int_rn(s2 * FX_S2)) << 32) + (long long)__float2int_rn(s1 * FX_S1);
                atomicAdd((unsigned long long*)stn + (size_t)row, (unsigned long long)packed); }
        }
    }
};

constexpr int NT_LAYER = 1600 + 512;
__device__ __forceinline__ void prep_tile_src(const P& p, int l, int tq, const float*& src, bf16_t*& dst, int& N, int& fold  , int& kbase, int& nbase, bool& is_win) {
    bf16_t* WinT = (bf16_t*)(p.ws + WS_WIN); bf16_t* WoutT = (bf16_t*)(p.ws + WS_WOUT);
    int kt, ntl; fold = l - 1;
    if (tq < 1600) { kt = tq / 100; ntl = tq % 100; N = DIN; src = p.w_in + (size_t)l * DM * DIN; dst = WinT + (size_t)l * DIN * DM; nbase = l * DIN + ntl * 64; is_win = true; }
    else { const int r = tq - 1600; kt = r / 32; ntl = r % 32; N = DM; src = p.w_out + (size_t)l * DM * DM; dst = WoutT + (size_t)l * DM * DM; nbase = ntl * 64; is_win = false; }
    kbase = kt * 128;
    src += (size_t)(kt * 128) * N + ntl * 64; dst += (size_t)(ntl * 64) * DM + kt * 128;
}
__device__ __forceinline__ void prep_weights(const P& p, LAS unsigned char* lds, int l0, int l1, int first, int stride) {
    int tid = threadIdx.x; asm volatile("" : "+v"(tid));
    LAS float* tile = (LAS float*)lds;
    LAS float* gsm = tile + 128 * 65;
    float* CS = (float*)(p.ws + WS_CS); float* BW = (float*)(p.ws + WS_BW);
    const int NT = (l1 - l0) * NT_LAYER;
    const int lr = tid >> 4, c4 = tid & 15;
    f32x4 pre[4];
    { int t = first; if (t < NT) { const float* src; bf16_t* dst; int N, fold, kb, nb; bool iw; prep_tile_src(p, l0 + t / NT_LAYER, t % NT_LAYER, src, dst, N, fold, kb, nb, iw);
#pragma unroll
        for (int ps = 0; ps < 4; ++ps) pre[ps] = *(const f32x4*)(src + (size_t)(lr + 32 * ps) * N + 4 * c4); } }
    for (int t = first; t < NT; t += stride) {
        const float* src; bf16_t* dst; int N, fold, kb, nb; bool is_win; prep_tile_src(p, l0 + t / NT_LAYER, t % NT_LAYER, src, dst, N, fold, kb, nb, is_win);
#pragma unroll
        for (int ps = 0; ps < 4; ++ps) { const int row = lr + 32 * ps;
            tile[row * 65 + 4 * c4 + 0] = pre[ps][0]; tile[row * 65 + 4 * c4 + 1] = pre[ps][1]; tile[row * 65 + 4 * c4 + 2] = pre[ps][2]; tile[row * 65 + 4 * c4 + 3] = pre[ps][3]; }
        if (tid < 256) { const int k = tid & 127; float v = (tid < 128) ? 1.0f : 0.0f;
            if (is_win && fold >= 0) v = (tid < 128) ? p.post_ln_g[fold * DM + kb + k] : p.post_ln_b[fold * DM + kb + k];
            gsm[tid] = v; }
        if (t + stride < NT) { const float* src2; bf16_t* dst2; int N2, f2, kb2, nb2; bool iw2; prep_tile_src(p, l0 + (t + stride) / NT_LAYER, (t + stride) % NT_LAYER, src2, dst2, N2, f2, kb2, nb2, iw2);
#pragma unroll
            for (int ps = 0; ps < 4; ++ps) pre[ps] = *(const f32x4*)(src2 + (size_t)(lr + 32 * ps) * N2 + 4 * c4); }
        __syncthreads();
#pragma unroll
        for (int ps = 0; ps < 2; ++ps) { const int idx = tid + 512 * ps; const int n = idx >> 4, k8 = idx & 15; float f[8]; float csp = 0.f, bwp = 0.f;
            const float cscale = (!is_win && fold >= 0) ? 1.0f / p.post_ln_g[fold * DM + nb + n] : 1.0f;
#pragma unroll
            for (int j = 0; j < 8; ++j) { const float w = tile[(8 * k8 + j) * 65 + n]; f[j] = w * gsm[8 * k8 + j] * cscale; csp += f[j]; bwp += w * gsm[128 + 8 * k8 + j]; }
            *(u32x4*)(dst + (size_t)n * DM + 8 * k8) = pack8(f);
            if (is_win && fold >= 0) {
                csp += __shfl_xor(csp, 1); csp += __shfl_xor(csp, 2); csp += __shfl_xor(csp, 4); csp += __shfl_xor(csp, 8);
                bwp += __shfl_xor(bwp, 1); bwp += __shfl_xor(bwp, 2); bwp += __shfl_xor(bwp, 4); bwp += __shfl_xor(bwp, 8);
                if (k8 == 0) { atomicAdd((int*)CS + nb + n, __float2int_rn(csp * FX_CS)); atomicAdd((int*)BW + nb + n, __float2int_rn(bwp * FX_CS)); } } }
        __syncthreads();
    }
}
__device__ __forceinline__ bool defer_prep() { return gridDim.x == 256; }
__device__ __forceinline__ void phase_prep(const P& p, LAS unsigned char* lds) {
    int tid = threadIdx.x; asm volatile("" : "+v"(tid)); const int G = gridDim.x, b = blockIdx.x;
    prep_weights(p, lds, 0, defer_prep() ? 1 : NLAYER, b, G);
    {
        bf16_t* BI = (bf16_t*)(p.ws + WS_BI);
        for (int c = b * 512 + tid; c < 256 * DM / 8; c += G * 512) { const int r = c >> 8, c8 = (c & 255) * 8; u32x4 w = (u32x4){0u, 0u, 0u, 0u};
            if (r >= c8 && r < c8 + 8) { const int j = r - c8; const unsigned one = 0x3F80u << ((j & 1) * 16); if ((j >> 1) == 0) w.x = one; else if ((j >> 1) == 1) w.y = one; else if ((j >> 1) == 2) w.z = one; else w.w = one; }
            *(u32x4*)(BI + (size_t)c * 8) = w; }
    }
    bf16_t* XB = (bf16_t*)(p.ws + WS_XB);
    constexpr size_t NCH = (size_t)MTOK * DM / 8, HALFCH = (size_t)ROWS_PROMPT * DM / 8;
    {
        f32x4 va[4], vb[4]; const size_t step = (size_t)G * 2048; size_t c = (size_t)b * 2048 + tid;
#define XCONV_LOADS(c_) do { _Pragma("unroll") for (int u = 0; u < 4; ++u) { const size_t cc = (c_) + 512 * u; const float* sp = cc < HALFCH ? p.x_prompt + cc * 8 : p.x_sample + (cc - HALFCH) * 8; va[u] = *(const f32x4*)sp; vb[u] = *(const f32x4*)(sp + 4); } } while (0)
        if (c < NCH) XCONV_LOADS(c);
        for (; c < NCH; c += step) {
            u32x4 w[4];
#pragma unroll
            for (int u = 0; u < 4; ++u) { w[u].x = pkh2(va[u][0], va[u][1]); w[u].y = pkh2(va[u][2], va[u][3]); w[u].z = pkh2(vb[u][0], vb[u][1]); w[u].w = pkh2(vb[u][2], vb[u][3]); }
            if (c + step < NCH) XCONV_LOADS(c + step);
#pragma unroll
            for (int u = 0; u < 4; ++u) *(u32x4*)(XB + (c + 512 * u) * 8) = w[u];
        }
#undef XCONV_LOADS
    }
    bf16_t* SW = (bf16_t*)(p.ws + WS_SGUW);
    for (int c = b * 512 + tid; c < NLAYER * 4 * 128 * 128 / 8; c += G * 512) {
        const float* sp = p.sgu_w + (size_t)c * 8; const f32x4 a = *(const f32x4*)sp, bq = *(const f32x4*)(sp + 4); u32x4 w; w.x = pkh2e(a[0], a[1]); w.y = pkh2e(a[2], a[3]); w.z = pkh2e(bq[0], bq[1]); w.w = pkh2e(bq[2], bq[3]);
        *(u32x4*)(SW + (size_t)c * 8) = w; }
}

constexpr int VN_PITCH = 520;
__device__ __forceinline__ void mixer_sgu(const P& p, int l, int row0, LAS unsigned char* lds) {
    int tid = threadIdx.x; asm volatile("" : "+v"(tid)); const int wave = tid >> 6, lane = tid & 63;
    const bf16_t* H = (const bf16_t*)(p.ws + WS_H); bf16_t* Y = (bf16_t*)(p.ws + WS_Y);
    LAS bf16_t* vn = (LAS bf16_t*)lds;
    bf16x8 wf[4][4];
    { const int hd = wave >> 1, th = wave & 1, r = lane & 15, q = lane >> 4;
      const bf16_t* W = (const bf16_t*)(p.ws + WS_SGUW) + (size_t)(l * 4 + hd) * 128 * 128;
#pragma unroll
      for (int ks = 0; ks < 4; ++ks)
#pragma unroll
          for (int tt = 0; tt < 4; ++tt) wf[ks][tt] = *(const bf16x8*)(W + (size_t)(64 * th + 16 * tt + r) * 128 + 32 * ks + 8 * q); }
    {
        float gg[8], bb[8];
        { const f32x4 g0 = *(const f32x4*)(p.sgu_ln_g + l * 512 + 8 * lane), g1 = *(const f32x4*)(p.sgu_ln_g + l * 512 + 8 * lane + 4);
          const f32x4 b0 = *(const f32x4*)(p.sgu_ln_b + l * 512 + 8 * lane), b1 = *(const f32x4*)(p.sgu_ln_b + l * 512 + 8 * lane + 4);
#pragma unroll
          for (int j = 0; j < 4; ++j) { gg[j] = g0[j]; gg[4 + j] = g1[j]; bb[j] = b0[j]; bb[4 + j] = b1[j]; } }
        u32x4 rawA[8], rawB[8];
#pragma unroll
        for (int i = 0; i < 8; ++i) rawA[i] = *(const u32x4*)(H + (size_t)(row0 + wave * 16 + i) * DIN + C_AV + 8 * lane);
#pragma unroll
        for (int i = 0; i < 8; ++i) rawB[i] = *(const u32x4*)(H + (size_t)(row0 + wave * 16 + 8 + i) * DIN + C_AV + 8 * lane);
#pragma unroll
        for (int i = 0; i < 16; ++i) { const int s = wave * 16 + i;
            float v[8]; if (i < 8) unpack8(rawA[i], v); else unpack8(rawB[i - 8], v);
            float sum = 0.f;
#pragma unroll
            for (int j = 0; j < 8; ++j) sum += v[j];
            const float mean = wave_sum(sum) * (1.0f / 512.0f);
            float q = 0.f;
#pragma unroll
            for (int j = 0; j < 8; ++j) { v[j] -= mean; q += v[j] * v[j]; }
            const float rstd = rsqrtf(wave_sum(q) * (1.0f / 512.0f) + LN_EPS);
#pragma unroll
            for (int j = 0; j < 8; ++j) v[j] = v[j] * rstd * gg[j] + bb[j];
            { u32x4 w; w.x = pkh2e(v[0], v[1]); w.y = pkh2e(v[2], v[3]); w.z = pkh2e(v[4], v[5]); w.w = pkh2e(v[6], v[7]); *(LAS u32x4*)(vn + s * VN_PITCH + 8 * lane) = w; } }
    }
    __syncthreads();
    {
        const int hd = wave >> 1, th = wave & 1, r = lane & 15, q = lane >> 4, qq = (lane >> 2) & 3, pp = lane & 3;
#pragma unroll 1
        for (int dh = 0; dh < 2; ++dh) {
        f32x4 acc[4][4];
#pragma unroll
        for (int a = 0; a < 4; ++a)
#pragma unroll
            for (int c = 0; c < 4; ++c) acc[a][c] = (f32x4){0.f, 0.f, 0.f, 0.f};
#pragma unroll
        for (int ks = 0; ks < 4; ++ks) {
#pragma unroll
            for (int dt = 0; dt < 4; ++dt) {
                const LAS bf16_t* ap = vn + (32 * ks + 8 * q + qq) * VN_PITCH + 128 * hd + 64 * dh + 32 * (dt >> 1) + 8 * pp + 4 * (dt & 1);
                const s16x4 lo = __builtin_amdgcn_ds_read_tr16_b64_v4i16((LAS s16x4*)ap);
                const s16x4 hi = __builtin_amdgcn_ds_read_tr16_b64_v4i16((LAS s16x4*)(ap + 4 * VN_PITCH));
                const bf16x8 af = {lo[0], lo[1], lo[2], lo[3], hi[0], hi[1], hi[2], hi[3]};
#pragma unroll
                for (int tt = 0; tt < 4; ++tt) acc[dt][tt] = pg8::mma16<true>(af, wf[ks][tt], acc[dt][tt]);
            }
        }
#pragma unroll
        for (int tt = 0; tt < 4; ++tt) { const int t = 64 * th + 16 * tt + r; const float bs = p.sgu_b[(l * 4 + hd) * 128 + t]; const float ysc = ((const LAS float*)(lds + LDS_YSC))[t];
            const bf16_t* hrow = H + (size_t)(row0 + t) * DIN; bf16_t* yrow = Y + (size_t)(row0 + t) * DM;
#pragma unroll
            for (int m = 0; m < 2; ++m) { const int d0 = 128 * hd + 64 * dh + 32 * m + 8 * q;
                const u32x4 uu = *(const u32x4*)(hrow + C_AU + d0), ag = *(const u32x4*)(hrow + C_AG + d0);
                float uv[8], gv[8], o[8]; unpack8(uu, uv); unpack8(ag, gv);
#pragma unroll
                for (int j = 0; j < 4; ++j) { o[j] = ysc * uv[j] * (acc[2 * m][tt][j] + bs) * gv[j]; o[4 + j] = ysc * uv[4 + j] * (acc[2 * m + 1][tt][j] + bs) * gv[4 + j]; }
                *(u32x4*)(yrow + d0) = pack8(o); } }
        }
    }
}

__device__ __forceinline__ void mixer_conf(const P& p, int l, int row0, int pos0, int S, LAS unsigned char* lds) {
    int tid = threadIdx.x; asm volatile("" : "+v"(tid)); const int wave = tid >> 6, lane = tid & 63;
    const bf16_t* H = (const bf16_t*)(p.ws + WS_H); bf16_t* Y = (bf16_t*)(p.ws + WS_Y);
    LAS float* gbuf = (LAS float*)lds;
    LAS float* cbuf = (LAS float*)(lds + 62 * 256 * 4);
    float lg[8], lb[8];
    { const f32x4 g0 = *(const f32x4*)(p.cm_ln_g + l * 512 + 8 * lane), g1 = *(const f32x4*)(p.cm_ln_g + l * 512 + 8 * lane + 4);
      const f32x4 b0 = *(const f32x4*)(p.cm_ln_b + l * 512 + 8 * lane), b1 = *(const f32x4*)(p.cm_ln_b + l * 512 + 8 * lane + 4);
#pragma unroll
      for (int j = 0; j < 4; ++j) { lg[j] = g0[j]; lg[4 + j] = g1[j]; lb[j] = b0[j]; lb[4 + j] = b1[j]; } }
    float cw[2][31], cbias[2];
    { const int c = tid & 255;
#pragma unroll
      for (int ch = 0; ch < 2; ++ch) { cbias[ch] = p.cm_conv_b[l * 512 + 256 * ch + c];
#pragma unroll
          for (int j = 0; j < 31; ++j) cw[ch][j] = p.cm_conv_w[(size_t)(l * 31 + j) * 512 + 256 * ch + c]; } }
    u32x4 sa[4], sb[4], sgt[4];
#define CONF_LOADS(sub_, ch_) do { _Pragma("unroll") for (int it = 0; it < 4; ++it) { const int i = tid + 512 * it; const int ri = i >> 5, c8 = i & 31; const int t = 32 * (sub_) - 15 + ri; const int pos = pos0 + t; \
        const bool ok = (i < 62 * 32) && pos >= 0 && pos < S; const bf16_t* hr = H + (size_t)(row0 + (ok ? t : 0)) * DIN + 256 * (ch_) + 8 * c8; sa[it] = *(const u32x4*)(hr + C_BA); sb[it] = *(const u32x4*)(hr + C_BB); } } while (0)
    CONF_LOADS(0, 0);
#pragma unroll 1
    for (int sub = 0; sub < 4; ++sub) { const int t0 = 32 * sub;
#pragma unroll
        for (int ch = 0; ch < 2; ++ch) {
#pragma unroll
            for (int it = 0; it < 4; ++it) { const int i = tid + 512 * it;
                const int ri = i >> 5, c8 = i & 31; const int t = t0 - 15 + ri; const int pos = pos0 + t;
                const bool ok = (i < 62 * 32) && pos >= 0 && pos < S;
                float a[8], bq[8], gv[8]; unpack8(sa[it], a); unpack8(sb[it], bq);
#pragma unroll
                for (int j = 0; j < 8; ++j) gv[j] = ok ? a[j] * bq[j] : 0.f;
                if (i < 62 * 32) { *(LAS f32x4*)(gbuf + ri * 256 + 8 * c8) = (f32x4){gv[0], gv[1], gv[2], gv[3]}; *(LAS f32x4*)(gbuf + ri * 256 + 8 * c8 + 4) = (f32x4){gv[4], gv[5], gv[6], gv[7]}; } }
            if (ch == 0) CONF_LOADS(sub, 1);
            else { if (sub < 3) CONF_LOADS(sub + 1, 0);
#pragma unroll
                for (int i = 0; i < 4; ++i) sgt[i] = *(const u32x4*)(H + (size_t)(row0 + t0 + 4 * wave + i) * DIN + C_BG + 8 * lane); }
            __syncthreads();
            { const int c = tid & 255, tg = tid >> 8, chn = 256 * ch + c;
                const float bias = cbias[ch];
                float acc[16];
#pragma unroll
                for (int tt = 0; tt < 16; ++tt) acc[tt] = bias;
#pragma unroll
                for (int i = 0; i < 46; ++i) { const float val = gbuf[(16 * tg + i) * 256 + c];
#pragma unroll
                    for (int tt = 0; tt < 16; ++tt) { const int j = i - tt; if (j >= 0 && j < 31) acc[tt] += cw[ch][j] * val; } }
#pragma unroll
                for (int tt = 0; tt < 16; ++tt) cbuf[(16 * tg + tt) * 512 + chn] = acc[tt]; }
            __syncthreads();
        }
#pragma unroll
        for (int i = 0; i < 4; ++i) { const int tk = 4 * wave + i;
            const f32x4 c0 = *(const LAS f32x4*)(cbuf + tk * 512 + 8 * lane), c1 = *(const LAS f32x4*)(cbuf + tk * 512 + 8 * lane + 4);
            float v[8] = {c0[0], c0[1], c0[2], c0[3], c1[0], c1[1], c1[2], c1[3]};
            float sum = 0.f;
#pragma unroll
            for (int j = 0; j < 8; ++j) sum += v[j];
            const float mean = wave_sum(sum) * (1.0f / 512.0f);
            float q = 0.f;
#pragma unroll
            for (int j = 0; j < 8; ++j) { v[j] -= mean; q += v[j] * v[j]; }
            const float rstd = rsqrtf(wave_sum(q) * (1.0f / 512.0f) + LN_EPS);
            const size_t row = (size_t)(row0 + t0 + tk);
            float gt[8]; unpack8(sgt[i], gt);
            const float ysc = ((const LAS float*)(lds + LDS_YSC))[t0 + tk];
#pragma unroll
            for (int j = 0; j < 8; ++j) { const float yv = v[j] * rstd * lg[j] + lb[j]; v[j] = ysc * silu_f(yv) * gt[j]; }
            *(u32x4*)(Y + row * DM + 512 + 8 * lane) = pack8(v); }
    }
#undef CONF_LOADS
}

constexpr int KP = 72, VP = 80, NKT = 18;
template <bool INTERIOR> __device__ __forceinline__ float attn_scores(f32x4 (&sacc)[NKT], float basef, float cminf, float cmaxf, float slope2) {
    float mx = -3.0e38f;
#pragma unroll
    for (int kt = 0; kt < NKT; ++kt)
#pragma unroll
        for (int jj = 0; jj < 4; ++jj) { const float c = (float)(16 * kt + jj); const float dist = fabsf(basef - c);
            float sc = sacc[kt][jj] * (0.125f * LOG2E) - slope2 * dist;
            if (!INTERIOR || kt < 2 || kt > 15) { const bool valid = (c >= cminf) && (c <= cmaxf); sc = valid ? sc : -1.0e30f; }
            sacc[kt][jj] = sc; mx = fmaxf(mx, sc); }
    return mx;
}
template <bool INTERIOR> __device__ __forceinline__ void mixer_attn(const P& p, int l, int row0, int pos0, int S, LAS unsigned char* lds) {
    int tid = threadIdx.x; asm volatile("" : "+v"(tid)); const int wave = tid >> 6, lane = tid & 63;
    const bf16_t* H = (const bf16_t*)(p.ws + WS_H); bf16_t* Y = (bf16_t*)(p.ws + WS_Y);
    LAS bf16_t* Kb = (LAS bf16_t*)lds;
    LAS bf16_t* Vb = (LAS bf16_t*)(lds + 384 * KP * 2);
    const int rq = lane & 15, q4 = lane >> 4, qq = (lane >> 2) & 3, pp = lane & 3;
#pragma unroll 1
    for (int g = 0; g < 2; ++g) {
        __syncthreads();
#pragma unroll
        for (int it = 0; it < 6; ++it) { const int i = tid + 512 * it; const int kk = i >> 3, c8 = i & 7; const int pos = pos0 - 128 + kk;
            const bool ok = pos >= 0 && pos < S;
            const bf16_t* hr = H + (size_t)(row0 + (ok ? kk - 128 : 0)) * DIN + 64 * g + 8 * c8;
            u32x4 kv = *(const u32x4*)(hr + C_K), vv = *(const u32x4*)(hr + C_V);
            const u32x4 zz = (u32x4){0u, 0u, 0u, 0u}; kv = ok ? kv : zz; vv = ok ? vv : zz;
            *(LAS u32x4*)(Kb + kk * KP + 8 * c8) = kv; *(LAS u32x4*)(Vb + kk * VP + 8 * c8) = vv; }
        const int head = 4 * g + (wave >> 1), qh = wave & 1;
        bf16x8 Qn[2];
        { const bf16_t* qp = H + (size_t)(row0 + 64 * qh + rq) * DIN + C_Q + 64 * head + 8 * q4; Qn[0] = *(const bf16x8*)qp; Qn[1] = *(const bf16x8*)(qp + 32); }
        const float slope2 = ex2(-(float)(head + 1)) * LOG2E;
        const float sink2 = p.attn_sink[l * 8 + head] * LOG2E;
        __syncthreads();
#pragma unroll 1
        for (int pass = 0; pass < 4; ++pass) { const int q0 = 64 * qh + 16 * pass;
            bf16x8 Qf[2]; Qf[0] = Qn[0]; Qf[1] = Qn[1];
            if (pass < 3) { const bf16_t* qp = H + (size_t)(row0 + q0 + 16 + rq) * DIN + C_Q + 64 * head + 8 * q4; Qn[0] = *(const bf16x8*)qp; Qn[1] = *(const bf16x8*)(qp + 32); }
            u32x2 gts[4];
#pragma unroll
            for (int dt = 0; dt < 4; ++dt) gts[dt] = *(const u32x2*)(H + (size_t)(row0 + q0 + rq) * DIN + C_CG + 64 * head + 16 * dt + 4 * q4);
            int t0k = q0 >> 4; if (t0k > 6) t0k = 6;
            const int kb0 = 16 * t0k;
            f32x4 sacc[NKT];
            const LAS bf16_t* kbase = Kb + (kb0 + rq) * KP + 8 * q4;
#pragma unroll
            for (int kt = 0; kt < NKT; ++kt) { const LAS bf16_t* kp = kbase + kt * (16 * KP);
                const bf16x8 k0 = *(const LAS bf16x8*)kp, k1 = *(const LAS bf16x8*)(kp + 32);
                f32x4 a = (f32x4){0.f, 0.f, 0.f, 0.f};
                a = __builtin_amdgcn_mfma_f32_16x16x32_bf16(k0, Qf[0], a, 0, 0, 0); a = __builtin_amdgcn_mfma_f32_16x16x32_bf16(k1, Qf[1], a, 0, 0, 0); sacc[kt] = a; }
            const int basei = 128 + q0 + rq - kb0 - 4 * q4;
            const int loi = -(pos0 - 128 + kb0 + 4 * q4), hii = loi + S - 1;
            const int cmin_i = max(loi, basei - 128), cmax_i = min(hii, basei + 128);
            const float basef = (float)basei, cminf = (float)cmin_i, cmaxf = (float)cmax_i;
            float mx = attn_scores<INTERIOR>(sacc, basef, cminf, cmaxf, slope2);
            mx = fmaxf(mx, __shfl_xor(mx, 16)); mx = fmaxf(mx, __shfl_xor(mx, 32));
            const float m2 = fmaxf(mx, sink2);
            float sum = 0.f;
#pragma unroll
            for (int kt = 0; kt < NKT; ++kt)
#pragma unroll
                for (int jj = 0; jj < 4; ++jj) { const float e = ex2(sacc[kt][jj] - m2); sacc[kt][jj] = e; sum += e; }
            sum += __shfl_xor(sum, 16); sum += __shfl_xor(sum, 32);
            const float inv = 1.0f / (sum + ex2(sink2 - m2));
            f32x4 o[4];
#pragma unroll
            for (int dt = 0; dt < 4; ++dt) o[dt] = (f32x4){0.f, 0.f, 0.f, 0.f};
            const LAS bf16_t* vbase = Vb + (kb0 + 4 * q4 + qq) * VP + 4 * pp;
#pragma unroll
            for (int s = 0; s < NKT / 2; ++s) {
                const f32x4 e0 = sacc[2 * s] * inv, e1 = sacc[2 * s + 1] * inv;
                u32x4 pw; pw.x = pk2(e0[0], e0[1]); pw.y = pk2(e0[2], e0[3]); pw.z = pk2(e1[0], e1[1]); pw.w = pk2(e1[2], e1[3]);
                const bf16x8 pf = __builtin_bit_cast(bf16x8, pw);
#pragma unroll
                for (int dt = 0; dt < 4; ++dt) { const LAS bf16_t* vp = vbase + s * (32 * VP) + 16 * dt;
                    const s16x4 lo = __builtin_amdgcn_ds_read_tr16_b64_v4i16((LAS s16x4*)vp);
                    const s16x4 hi = __builtin_amdgcn_ds_read_tr16_b64_v4i16((LAS s16x4*)(vp + 16 * VP));
                    const bf16x8 vf = {lo[0], lo[1], lo[2], lo[3], hi[0], hi[1], hi[2], hi[3]};
                    o[dt] = __builtin_amdgcn_mfma_f32_16x16x32_bf16(vf, pf, o[dt], 0, 0, 0); }
            }
            { const size_t row = (size_t)(row0 + q0 + rq); const float ysc = ((const LAS float*)(lds + LDS_YSC))[q0 + rq];
#pragma unroll
                for (int dt = 0; dt < 4; ++dt) { const int chn = 64 * head + 16 * dt + 4 * q4;
                    const float g0 = bflo(gts[dt].x), g1 = bfhi(gts[dt].x), g2 = bflo(gts[dt].y), g3 = bfhi(gts[dt].y);
                    u32x2 w; w.x = pk2(ysc * o[dt][0] * g0, ysc * o[dt][1] * g1); w.y = pk2(ysc * o[dt][2] * g2, ysc * o[dt][3] * g3);
                    *(u32x2*)(Y + row * DM + 1024 + chn) = w; } }
        }
    }
}

#define SC_LOADP(dst, t_) do { const int _t = (t_); const int _pos = pos0 + _t; const bool _ok = _pos >= 0 && _pos < S; \
        const bf16_t* _hr = H + (size_t)(row0 + (_ok ? _t : 0)) * DIN + c0; const u32x4 _rc = *(const u32x4*)(_hr + C_DC), _rx = *(const u32x4*)(_hr + C_DX); float _c[8], _x[8]; unpack8(_rc, _c); unpack8(_rx, _x); \
        _Pragma("unroll") for (int _j = 0; _j < 8; ++_j) dst[_j] = _ok ? _c[_j] * _x[_j] : 0.f; } while (0)
__device__ __forceinline__ void mixer_sconv(const P& p, int l, int row0, int pos0, int S, LAS unsigned char* lds) {
    int tid = threadIdx.x; asm volatile("" : "+v"(tid)); const int wave = tid >> 6, lane = tid & 63, c0 = 8 * lane;
    const bf16_t* H = (const bf16_t*)(p.ws + WS_H); bf16_t* Y = (bf16_t*)(p.ws + WS_Y);
    float w0[8], w1[8], w2[8];
    { const float* wp = p.sc_conv_w + (size_t)l * 3 * 512 + c0;
#pragma unroll
      for (int j = 0; j < 8; ++j) { w0[j] = wp[j]; w1[j] = wp[512 + j]; w2[j] = wp[1024 + j]; } }
    const int tb = 16 * wave;
    float prev[8], cur[8];
    u32x4 rcA[2], rxA[2], rbA[2], rgA[2], rcB[2], rxB[2], rbB[2], rgB[2], rcC[2], rxC[2], rbC[2], rgC[2];
#define SC_BATCH(k_, rc, rx, rb, rg) do { _Pragma("unroll") for (int u = 0; u < 2; ++u) { const int t = tb + 2 * (k_) + u; const int pn1 = pos0 + t + 1; const bool okn = pn1 >= 0 && pn1 < S; \
        const bf16_t* hn = H + (size_t)(row0 + (okn ? t + 1 : 0)) * DIN + c0; rc[u] = *(const u32x4*)(hn + C_DC); rx[u] = *(const u32x4*)(hn + C_DX); \
        const bf16_t* hr = H + (size_t)(row0 + t) * DIN + c0; rb[u] = *(const u32x4*)(hr + C_DB); rg[u] = *(const u32x4*)(hr + C_DG); } } while (0)
#define SC_COMPUTE(k_, rc, rx, rb, rg) do { _Pragma("unroll") for (int u = 0; u < 2; ++u) { const int t = tb + 2 * (k_) + u; const int pn1 = pos0 + t + 1; const bool okn = pn1 >= 0 && pn1 < S; \
        float cc[8], xx[8], bv[8], gv[8], o[8]; unpack8(rc[u], cc); unpack8(rx[u], xx); unpack8(rb[u], bv); unpack8(rg[u], gv); const float ysc = ((const LAS float*)(lds + LDS_YSC))[t]; \
        _Pragma("unroll") for (int j = 0; j < 8; ++j) { const float nx = okn ? cc[j] * xx[j] : 0.f; const float cv = w0[j] * prev[j] + w1[j] * cur[j] + w2[j] * nx; o[j] = ysc * bv[j] * cv * gv[j]; prev[j] = cur[j]; cur[j] = nx; } \
        *(u32x4*)(Y + (size_t)(row0 + t) * DM + 1536 + c0) = pack8(o); } } while (0)
    SC_BATCH(0, rcA, rxA, rbA, rgA); SC_BATCH(1, rcB, rxB, rbB, rgB);
    SC_LOADP(prev, tb - 1); SC_LOADP(cur, tb);
    SC_BATCH(2, rcC, rxC, rbC, rgC); SC_COMPUTE(0, rcA, rxA, rbA, rgA);
    SC_BATCH(3, rcA, rxA, rbA, rgA); SC_COMPUTE(1, rcB, rxB, rbB, rgB);
    SC_BATCH(4, rcB, rxB, rbB, rgB); SC_COMPUTE(2, rcC, rxC, rbC, rgC);
    SC_BATCH(5, rcC, rxC, rbC, rgC); SC_COMPUTE(3, rcA, rxA, rbA, rgA);
    SC_BATCH(6, rcA, rxA, rbA, rgA); SC_COMPUTE(4, rcB, rxB, rbB, rgB);
    SC_BATCH(7, rcB, rxB, rbB, rgB); SC_COMPUTE(5, rcC, rxC, rbC, rgC);
    SC_COMPUTE(6, rcA, rxA, rbA, rgA); SC_COMPUTE(7, rcB, rxB, rbB, rgB);
#undef SC_BATCH
#undef SC_COMPUTE
}

__device__ __forceinline__ void phase_mixers(const P& p, int l, LAS unsigned char* lds) {
    for (int blk = blockIdx.x; blk < MTOK / 128; blk += gridDim.x) {
        const int row0 = blk * 128; int pos0, S; seq_of_row(row0, pos0, S);
        __syncthreads();
        if (threadIdx.x < 128) { float sc = 1.0f / ALPHA;
            if (l > 0) { float mean, rstd; row_mean_rstd((const float*)(p.ws + WS_STATS) + (size_t)(l - 1) * MTOK * 2, row0 + (int)threadIdx.x, mean, rstd); sc = 1.0f / (ALPHA * rstd); }
            ((LAS float*)(lds + LDS_YSC))[threadIdx.x] = sc; }
        __syncthreads();
        mixer_sgu(p, l, row0, lds);
#ifdef PROBE_SGU2
        __syncthreads(); mixer_sgu(p, l, row0, lds);
#endif
        __syncthreads();
        mixer_conf(p, l, row0, pos0, S, lds);
#ifdef PROBE_CONF2
        __syncthreads(); mixer_conf(p, l, row0, pos0, S, lds);
#endif
        if ((pos0 >= 128) && (pos0 + 256 <= S)) mixer_attn<true>(p, l, row0, pos0, S, lds); else mixer_attn<false>(p, l, row0, pos0, S, lds);
        mixer_sconv(p, l, row0, pos0, S, lds);
    }
}

__device__ __forceinline__ void phase_final_ln(const P& p) {
    int tid = threadIdx.x; asm volatile("" : "+v"(tid)); const int wave = tid >> 6, lane = tid & 63;
    const int l = NLAYER - 1; const float* st = (const float*)(p.ws + WS_STATS) + (size_t)l * MTOK * 2;
    f32x4 gg[8], bb[8];
#pragma unroll
    for (int j = 0; j < 8; ++j) { gg[j] = *(const f32x4*)(p.post_ln_g + l * DM + 4 * lane + 256 * j); bb[j] = *(const f32x4*)(p.post_ln_b + l * DM + 4 * lane + 256 * j); }
    {
        u32x2 hv[2][8]; const int rstep = gridDim.x * 16; int row = (blockIdx.x * 8 + wave) * 2;
#define FLN_LOADS(row_) do { const bf16_t* zs = (const bf16_t*)(p.ws + WS_XB) + (size_t)(row_) * DM + 4 * lane; _Pragma("unroll") for (int rr = 0; rr < 2; ++rr) _Pragma("unroll") for (int j = 0; j < 8; ++j) hv[rr][j] = *(const u32x2*)(zs + (size_t)rr * DM + 256 * j); } while (0)
        if (row < MTOK) FLN_LOADS(row);
        for (; row < MTOK; row += rstep) {
            float* zr = p.out + (size_t)row * DM + 4 * lane;
            f32x4 v[2][8];
#pragma unroll
            for (int rr = 0; rr < 2; ++rr)
#pragma unroll
                for (int j = 0; j < 8; ++j) { const f16x4e hq = __builtin_bit_cast(f16x4e, hv[rr][j]); v[rr][j] = (f32x4){(float)hq[0], (float)hq[1], (float)hq[2], (float)hq[3]}; }
            float mean[2], rstd[2]; row_mean_rstd(st, row, mean[0], rstd[0]); row_mean_rstd(st, row + 1, mean[1], rstd[1]);
            if (row + rstep < MTOK) FLN_LOADS(row + rstep);
#pragma unroll
            for (int rr = 0; rr < 2; ++rr)
#pragma unroll
                for (int j = 0; j < 8; ++j) *(f32x4*)(zr + (size_t)rr * DM + 256 * j) = (v[rr][j] - mean[rr]) * rstd[rr] * gg[j] + bb[j];
        }
#undef FLN_LOADS
    }
}

__global__ void __launch_bounds__(512, 2) mega(P p_arg) {
    extern __shared__ __attribute__((aligned(16))) unsigned char smem[];
    LAS unsigned char* lds = (LAS unsigned char*)smem;
    cg::grid_group grid = cg::this_grid();
    const KArgPtr kp = (KArgPtr)__builtin_amdgcn_kernarg_segment_ptr();
    const int ph_lo = p_arg.ph_lo, ph_hi = p_arg.ph_hi;
    unsigned* barw = (unsigned*)(p_arg.ws + WS_BAR);
#define RUN(k) (ph_lo <= (k) && (k) < ph_hi)
    volatile LAS unsigned* barst = (volatile LAS unsigned*)(lds + LDS_BARST);
    XcdBarrier xb; xb.bar = barw; xb.x = 0; xb.st = barst;
    if (threadIdx.x < 2) barst[threadIdx.x] = 0u;
    __syncthreads();
    if (MK_COOP) xb = xcd_barrier_post(barw, barst);
#define SEAM(k) do { if (MK_COOP && RUN(k) && RUN((k) + 1)) { if ((k) == 0) grid.sync(); xcd_barrier(xb); } } while (0)
    if (RUN(0)) { const P p = load_params(kp); phase_prep(p, lds);
#ifdef PROBE_PREP2
        __syncthreads(); phase_prep(p, lds);
#endif
        SEAM(0); }
#pragma unroll 1
    for (int l = 0; l < NLAYER; ++l) {
        const int k = 1 + 3 * l;
        if (RUN(k)) {
            const P p = load_params(kp);
            pg8::Gemm g{(const bf16_t*)(p.ws + WS_XB), (const bf16_t*)(p.ws + WS_WIN) + (size_t)l * DIN * DM, MTOK, DIN, DM, (const bf16_t*)(p.ws + WS_XB), (const bf16_t*)(p.ws + WS_BI), 0};
            EpiH E{kp, l};
#ifdef PROBE_G1X2
            Order2 So; So.init(MTOK, DIN, gridDim.x, blockIdx.x);
            __syncthreads();
            pg8::gemm_phase<EpiH, Order2, false>(lds, g, So, E, nullptr);
#else
            pg8::StaticOrder So; So.init(MTOK, DIN, gridDim.x, blockIdx.x);
            __syncthreads();
            pg8::gemm_phase<EpiH, pg8::StaticOrder, false>(lds, g, So, E, nullptr);
            if (defer_prep() && l + 1 < NLAYER && blockIdx.x >= 128) { __syncthreads(); prep_weights(p, lds, l + 1, l + 2, (int)blockIdx.x - 128, 128); }
#endif
            SEAM(k);
        }
        if (RUN(k + 1)) { const P p = load_params(kp); phase_mixers(p, l, lds);
#ifdef PROBE_MIX2
            __syncthreads(); phase_mixers(p, l, lds);
#endif
            SEAM(k + 1); }
        if (RUN(k + 2)) {
            const P p = load_params(kp);
            pg8::Gemm g{(const bf16_t*)(p.ws + WS_Y), (const bf16_t*)(p.ws + WS_WOUT) + (size_t)l * DM * DM, MTOK, DM, DM, (const bf16_t*)(p.ws + WS_XB), (const bf16_t*)(p.ws + WS_BI), PROBE_NTE};
            pg8::StaticOrder So; So.init(MTOK, DM, gridDim.x, blockIdx.x);
            EpiZ E{kp, l};
            __syncthreads();
            pg8::gemm_phase<EpiZ, pg8::StaticOrder, false>(lds, g, So, E, nullptr);
            SEAM(k + 2);
        }
    }
    if (RUN(NPHASE - 1)) { const P p = load_params(kp); phase_final_ln(p); }
#undef RUN
#undef SEAM
}

extern "C" void kernel_launch(void* const* d_in, const int* in_sizes, int n_in, void* d_out, int out_size, void* d_ws, size_t ws_size, hipStream_t stream) {
    static int grid_blocks = 0;
    if (grid_blocks == 0) {
        if (n_in != 16 || out_size != MTOK * DM || ws_size < WS_END2) { fprintf(stderr, "kernel_launch: unexpected shapes (n_in %d out %d ws %zu need %zu)\n", n_in, out_size, ws_size, (size_t)WS_END2); grid_blocks = -1; return; }
        int dev = 0, cus = 0, per_cu = 0;
        (void)hipGetDevice(&dev); (void)hipDeviceGetAttribute(&cus, hipDeviceAttributeMultiprocessorCount, dev);
        if (hipFuncSetAttribute((const void*)mega, hipFuncAttributeMaxDynamicSharedMemorySize, LDS_BYTES) != hipSuccess) { fprintf(stderr, "kernel_launch: hipFuncSetAttribute failed\n"); grid_blocks = -1; return; }
        if (hipOccupancyMaxActiveBlocksPerMultiprocessor(&per_cu, (const void*)mega, 512, LDS_BYTES) != hipSuccess || per_cu < 1) per_cu = 1;
        (void)hipGetLastError();
        if (cus <= 0) cus = 256;
        grid_blocks = cus * per_cu;
    }
    if (grid_blocks < 0) return;
    P p{};
    p.x_prompt = (const float*)d_in[0]; p.x_sample = (const float*)d_in[1]; p.w_in = (const float*)d_in[2]; p.w_out = (const float*)d_in[3];
    p.sgu_ln_g = (const float*)d_in[4]; p.sgu_ln_b = (const float*)d_in[5]; p.sgu_w = (const float*)d_in[6]; p.sgu_b = (const float*)d_in[7];
    p.cm_conv_w = (const float*)d_in[8]; p.cm_conv_b = (const float*)d_in[9]; p.cm_ln_g = (const float*)d_in[10]; p.cm_ln_b = (const float*)d_in[11];
    p.attn_sink = (const float*)d_in[12]; p.sc_conv_w = (const float*)d_in[13]; p.post_ln_g = (const float*)d_in[14]; p.post_ln_b = (const float*)d_in[15];
    p.out = (float*)d_out; p.ws = (unsigned char*)d_ws;
    if (hipMemsetAsync((char*)d_ws + WS_CTL, 0, CTL_BYTES, stream) != hipSuccess) { fprintf(stderr, "kernel_launch: memset failed\n"); return; }
#if MK_COOP
    p.ph_lo = 0; p.ph_hi = NPHASE;
    void* args[] = {&p};
    hipError_t e = hipLaunchCooperativeKernel((const void*)mega, dim3(grid_blocks), dim3(512), args, LDS_BYTES, stream);
    if (e != hipSuccess) fprintf(stderr, "cooperative launch failed: %s (grid %d)\n", hipGetErrorString(e), grid_blocks);
#else
    for (int k = 0; k < NPHASE; ++k) { p.ph_lo = k; p.ph_hi = k + 1; hipLaunchKernelGGL(mega, dim3(grid_blocks), dim3(512), LDS_BYTES, stream, p); }
#endif
}
```
